# Optimizing an MI355X kernel written in HIP

```python
import jax
import jax.numpy as jnp
from jax import lax
import numpy as np

D_MODEL = 1024
BATCH = 16
SEQ = 2048
DEPTH = 2

N_BRANCH = 4
BRANCH_W = 512
EPS = 1e-6
ROPE_THETA = 10000.0
CHUNK = 128

CONV_DIM = 512
CONV_W = 3
RET_HEADS = 4
RET_DK = 64
RET_DV = 128
SG_DIM = 512
SG_GROUPS = 4
SG_GROUP_DIM = SG_DIM // SG_GROUPS
MLA_HEADS = 8
MLA_NOPE = 64
MLA_ROPE = 32
MLA_V = 64
MLA_Q_RANK = 384
MLA_KV_RANK = 256
Q_BLOCK = 128
D_FF = ((8 * D_MODEL // 3 + 255) // 256) * 256

SPLIT_SIZES = (CONV_DIM, CONV_DIM, CONV_DIM,
               RET_HEADS * RET_DK, RET_HEADS * RET_DK, RET_HEADS * RET_DV, RET_HEADS * RET_DV,
               SG_DIM, SG_DIM,
               MLA_Q_RANK, MLA_KV_RANK, MLA_ROPE,
               N_BRANCH * D_MODEL)
N_IN = int(sum(SPLIT_SIZES))
SPLIT_POINTS = tuple(int(v) for v in np.cumsum(SPLIT_SIZES)[:-1])

kernel_name = 'hybrid_gated_mixer_block'


def rms_norm(x, g):
    xf = x.astype(jnp.float32)
    y = xf * lax.rsqrt(jnp.mean(xf * xf, axis=-1, keepdims=True) + EPS)
    return (y * g.astype(jnp.float32)).astype(x.dtype)


def ln_plain(x):
    xf = x.astype(jnp.float32)
    mu = jnp.mean(xf, axis=-1, keepdims=True)
    var = jnp.mean(jnp.square(xf - mu), axis=-1, keepdims=True)
    return (xf - mu) * lax.rsqrt(var + EPS)


def layer_norm(x, g, b):
    return (ln_plain(x) * g.astype(jnp.float32) + b.astype(jnp.float32)).astype(x.dtype)


def rope_tables(positions, dim):
    inv = ROPE_THETA ** (-jnp.arange(0, dim, 2, dtype=jnp.float32) / dim)
    ang = positions.astype(jnp.float32)[..., None] * inv
    return jnp.cos(ang), jnp.sin(ang)


def apply_rope(x, cos, sin):
    c = cos[:, :, None, :]
    s = sin[:, :, None, :]
    x1, x2 = jnp.split(x, 2, axis=-1)
    out = jnp.concatenate([x1 * c - x2 * s, x1 * s + x2 * c], axis=-1)
    return out.astype(x.dtype)


def causal_conv(x, w):
    seq = x.shape[1]
    xp = jnp.pad(x, ((0, 0), (CONV_W - 1, 0), (0, 0)))
    return sum(w[i] * xp[:, i:i + seq] for i in range(CONV_W))


def retention(q, k, v, cos, sin):
    bsz, seq = q.shape[0], q.shape[1]
    n_chunks = seq // CHUNK
    q = apply_rope(q, cos, sin)
    k = apply_rope(k, cos, sin) * (RET_DK ** -0.5)
    q = q.reshape(bsz, n_chunks, CHUNK, RET_HEADS, RET_DK)
    k = k.reshape(bsz, n_chunks, CHUNK, RET_HEADS, RET_DK)
    v = v.reshape(bsz, n_chunks, CHUNK, RET_HEADS, RET_DV)
    log_gamma = jnp.log1p(-jnp.exp2(-5.0 - jnp.arange(RET_HEADS, dtype=jnp.float32)))
    idx = jnp.arange(CHUNK, dtype=jnp.float32)
    diff = idx[:, None] - idx[None, :]
    decay = jnp.where(diff >= 0, jnp.exp(jnp.maximum(diff, 0.0)[None] * log_gamma[:, None, None]), 0.0)
    scores = jnp.einsum('bnihd,bnjhd->bnhij', q, k) * decay
    o_inner = jnp.einsum('bnhij,bnjhe->bnihe', scores, v)
    zeta = jnp.exp((CHUNK - 1 - idx)[:, None] * log_gamma[None, :])
    xi = jnp.exp((idx + 1.0)[:, None] * log_gamma[None, :])
    chunk_decay = jnp.exp(CHUNK * log_gamma)
    kv = jnp.einsum('bnjhd,bnjhe,jh->nbhde', k, v, zeta).astype(jnp.float32)

    def step(state, kv_n):
        return chunk_decay[None, :, None, None] * state + kv_n, state

    init = jnp.zeros((bsz, RET_HEADS, RET_DK, RET_DV), jnp.float32)
    _, prev_states = lax.scan(step, init, kv)
    o_cross = jnp.einsum('bnihd,nbhde,ih->bnihe', q, prev_states, xi)
    o = ln_plain(o_inner + o_cross).astype(v.dtype)
    return o.reshape(bsz, seq, RET_HEADS * RET_DV)


def spatial_gating(u, v, ln_g, ln_b, ws, bs):
    bsz, seq = u.shape[0], u.shape[1]
    n_chunks = seq // CHUNK
    v = layer_norm(v, ln_g, ln_b).reshape(bsz, n_chunks, CHUNK, SG_GROUPS, SG_GROUP_DIM)
    w = jnp.tril(ws)
    s = jnp.einsum('gij,bnjgd->bnigd', w, v) + bs.T[None, None, :, :, None]
    return u * s.reshape(bsz, seq, SG_DIM)


def mla(c_q, c_kv, k_pe, q_norm, w_uq, kv_norm, w_ukv, cos, sin):
    bsz, seq = c_q.shape[0], c_q.shape[1]
    q = (rms_norm(c_q, q_norm) @ w_uq).reshape(bsz, seq, MLA_HEADS, MLA_NOPE + MLA_ROPE)
    q_nope, q_pe = q[..., :MLA_NOPE], apply_rope(q[..., MLA_NOPE:], cos, sin)
    kv = (rms_norm(c_kv, kv_norm) @ w_ukv).reshape(bsz, seq, MLA_HEADS, MLA_NOPE + MLA_V)
    k_nope, v = kv[..., :MLA_NOPE], kv[..., MLA_NOPE:]
    k_pe = apply_rope(k_pe[:, :, None, :], cos, sin)[:, :, 0]
    scale = (MLA_NOPE + MLA_ROPE) ** -0.5
    outs = []
    for blk in range(seq // Q_BLOCK):
        q0 = blk * Q_BLOCK
        kend = q0 + Q_BLOCK
        s = (jnp.einsum('bqhd,bkhd->bhqk', q_nope[:, q0:kend], k_nope[:, :kend])
             + jnp.einsum('bqhd,bkd->bhqk', q_pe[:, q0:kend], k_pe[:, :kend]))
        s = s.astype(jnp.float32) * scale
        mask = jnp.arange(kend)[None, :] <= (q0 + jnp.arange(Q_BLOCK))[:, None]
        s = jnp.where(mask, s, jnp.float32(-1e30))
        p = jax.nn.softmax(s, axis=-1).astype(v.dtype)
        outs.append(jnp.einsum('bhqk,bkhd->bqhd', p, v[:, :kend]))
    o = jnp.concatenate(outs, axis=1)
    return o.reshape(bsz, seq, MLA_HEADS * MLA_V)


def hybrid_layer(x, cos_r, sin_r, cos_m, sin_m, norm_mix, w_in, b_gate, conv_w,
                 sg_ln_g, sg_ln_b, sg_ws, sg_b, mla_q_norm, mla_w_uq, mla_kv_norm, mla_w_ukv,
                 w_branch, w_out, norm_ffn, w_ffn_in, w_ffn_out):
    bsz, seq = x.shape[0], x.shape[1]
    h = rms_norm(x, norm_mix)
    proj = h @ w_in
    (a_b, a_c, a_x, r_q, r_k, r_v, r_g, s_u, s_v,
     m_cq, m_ckv, m_kpe, gate_logits) = jnp.split(proj, SPLIT_POINTS, axis=-1)
    y_a = a_b * causal_conv(a_c * a_x, conv_w)
    y_r = jax.nn.silu(r_g) * retention(
        r_q.reshape(bsz, seq, RET_HEADS, RET_DK), r_k.reshape(bsz, seq, RET_HEADS, RET_DK),
        r_v.reshape(bsz, seq, RET_HEADS, RET_DV), cos_r, sin_r)
    y_s = spatial_gating(jax.nn.gelu(s_u), jax.nn.gelu(s_v), sg_ln_g, sg_ln_b, sg_ws, sg_b)
    y_m = mla(m_cq, m_ckv, m_kpe, mla_q_norm, mla_w_uq, mla_kv_norm, mla_w_ukv, cos_m, sin_m)
    gates = jax.nn.sigmoid(gate_logits.reshape(bsz, seq, N_BRANCH, D_MODEL) + b_gate)
    merged = sum(gates[:, :, i] * (y @ w_branch[i]) for i, y in enumerate((y_a, y_r, y_s, y_m)))
    x = x + merged @ w_out
    g, u = jnp.split(rms_norm(x, norm_ffn) @ w_ffn_in, 2, axis=-1)
    return x + (jax.nn.silu(g) * u) @ w_ffn_out


def setup_inputs(seed: int = 0) -> dict:
    key = jax.random.key(seed)
    ks = jax.random.split(key, 24)
    f32 = jnp.float32

    def nrm(k, shape, scale):
        return jax.random.normal(k, shape, f32) * scale

    def gain(k, shape):
        return 1.0 + 0.02 * jax.random.normal(k, shape, f32)

    offsets = jax.random.randint(ks[1], (BATCH, 1), 0, 4096, dtype=jnp.int32)
    positions = offsets + jnp.arange(SEQ, dtype=jnp.int32)[None, :]
    return {
        'x': jax.random.normal(ks[0], (BATCH, SEQ, D_MODEL), f32),
        'positions': positions,
        'norm_mix': gain(ks[2], (DEPTH, D_MODEL)),
        'w_in': nrm(ks[3], (DEPTH, D_MODEL, N_IN), D_MODEL ** -0.5),
        'b_gate': nrm(ks[4], (DEPTH, N_BRANCH, D_MODEL), 0.02),
        'conv_w': nrm(ks[5], (DEPTH, CONV_W, CONV_DIM), CONV_W ** -0.5),
        'sg_ln_g': gain(ks[6], (DEPTH, SG_DIM)),
        'sg_ln_b': nrm(ks[7], (DEPTH, SG_DIM), 0.02),
        'sg_ws': nrm(ks[8], (DEPTH, SG_GROUPS, CHUNK, CHUNK), CHUNK ** -0.5),
        'sg_b': gain(ks[9], (DEPTH, SG_GROUPS, CHUNK)),
        'mla_q_norm': gain(ks[10], (DEPTH, MLA_Q_RANK)),
        'mla_w_uq': nrm(ks[11], (DEPTH, MLA_Q_RANK, MLA_HEADS * (MLA_NOPE + MLA_ROPE)), MLA_Q_RANK ** -0.5),
        'mla_kv_norm': gain(ks[12], (DEPTH, MLA_KV_RANK)),
        'mla_w_ukv': nrm(ks[13], (DEPTH, MLA_KV_RANK, MLA_HEADS * (MLA_NOPE + MLA_V)), MLA_KV_RANK ** -0.5),
        'w_branch': nrm(ks[14], (DEPTH, N_BRANCH, BRANCH_W, D_MODEL), BRANCH_W ** -0.5),
        'w_out': nrm(ks[15], (DEPTH, D_MODEL, D_MODEL), D_MODEL ** -0.5),
        'norm_ffn': gain(ks[16], (DEPTH, D_MODEL)),
        'w_ffn_in': nrm(ks[17], (DEPTH, D_MODEL, 2 * D_FF), D_MODEL ** -0.5),
        'w_ffn_out': nrm(ks[18], (DEPTH, D_FF, D_MODEL), D_FF ** -0.5),
        'final_norm': gain(ks[19], (D_MODEL,)),
    }


def reference(x, positions, norm_mix, w_in, b_gate, conv_w, sg_ln_g, sg_ln_b, sg_ws, sg_b,
              mla_q_norm, mla_w_uq, mla_kv_norm, mla_w_ukv, w_branch, w_out, norm_ffn,
              w_ffn_in, w_ffn_out, final_norm):
    cos_r, sin_r = rope_tables(positions, RET_DK)
    cos_m, sin_m = rope_tables(positions, MLA_ROPE)
    for l in range(DEPTH):
        x = hybrid_layer(x, cos_r, sin_r, cos_m, sin_m, norm_mix[l], w_in[l], b_gate[l], conv_w[l],
                         sg_ln_g[l], sg_ln_b[l], sg_ws[l], sg_b[l], mla_q_norm[l], mla_w_uq[l],
                         mla_kv_norm[l], mla_w_ukv[l], w_branch[l], w_out[l], norm_ffn[l],
                         w_ffn_in[l], w_ffn_out[l])
    return rms_norm(x, final_norm)
```

```cpp
#include <hip/hip_runtime.h>
#include <hip/hip_cooperative_groups.h>
#include <cstdio>
#include <cstdint>
namespace cg = cooperative_groups;

#define LAS __attribute__((address_space(3)))
#define PG8_LAS __attribute__((address_space(3)))
typedef unsigned short bf16_t;
typedef short bf16x8 __attribute__((ext_vector_type(8)));
typedef float f32x4 __attribute__((ext_vector_type(4)));
typedef float f32x2 __attribute__((ext_vector_type(2)));
typedef unsigned u32x4 __attribute__((ext_vector_type(4)));
typedef unsigned u32x2 __attribute__((ext_vector_type(2)));

constexpr int DM = 1024, SEQ = 2048, NBATCH = 16, MTOT = NBATCH * SEQ, MH = MTOT / 2, NIN = 8864, DFF = 2816, NLAYER = 2;
constexpr int LDP = 3584;
constexpr int PC_AB = 0, PC_CX = 512, PC_RQ = 1024, PC_RK = 1280, PC_RV = 1536, PC_RG = 2048, PC_SU = 2560, PC_SV = 3072;
constexpr int NA_PHYS = 4864;
constexpr float EPS = 1e-6f;
constexpr float QSCALE = 0.10206207261596577f * 1.4426950408889634f;

__device__ __forceinline__ float bf2f(unsigned b) { return __uint_as_float(b << 16); }
__device__ __forceinline__ float bflo(unsigned w) { return __uint_as_float(w << 16); }
__device__ __forceinline__ float bfhi(unsigned w) { return __uint_as_float(w & 0xffff0000u); }
typedef __bf16 bf16x2_t __attribute__((ext_vector_type(2)));
__device__ __forceinline__ unsigned cvt_pk_bf16(float lo, float hi) { const f32x2 v = {lo, hi}; return __builtin_bit_cast(unsigned, __builtin_convertvector(v, bf16x2_t)); }
__device__ __forceinline__ unsigned f2bf(float f) { unsigned u = __float_as_uint(f); return (u + 0x7fffu + ((u >> 16) & 1u)) >> 16; }
__device__ __forceinline__ float fast_exp2(float x) { return __builtin_amdgcn_exp2f(x); }
__device__ __forceinline__ float fast_rcp(float x) { return __builtin_amdgcn_rcpf(x); }
__device__ __forceinline__ float sigmoidf_(float x) { return fast_rcp(1.0f + fast_exp2(-1.4426950408889634f * x)); }
__device__ __forceinline__ float siluf_(float x) { return x * sigmoidf_(x); }
__device__ __forceinline__ float geluf_(float x) { const float u = 0.7978845608028654f * (x + 0.044715f * x * x * x); return x * sigmoidf_(2.0f * u); }
__device__ __forceinline__ f32x4 sigmoid4(const f32x4 x) { const f32x4 t = x * (-1.4426950408889634f); f32x4 e; e[0] = fast_exp2(t[0]); e[1] = fast_exp2(t[1]); e[2] = fast_exp2(t[2]); e[3] = fast_exp2(t[3]);
    const f32x4 d = e + 1.0f; f32x4 r; r[0] = fast_rcp(d[0]); r[1] = fast_rcp(d[1]); r[2] = fast_rcp(d[2]); r[3] = fast_rcp(d[3]); return r; }
__device__ __forceinline__ f32x4 silu4(const f32x4 x) { return x * sigmoid4(x); }
__device__ __forceinline__ f32x4 gelu4(const f32x4 x) { const f32x4 u = (x * x * 0.044715f + 1.0f) * x * (2.0f * 0.7978845608028654f); return x * sigmoid4(u); }
__device__ __forceinline__ float wave_sum(float v) {
#pragma unroll
    for (int o = 1; o < 64; o <<= 1) v += __shfl_xor(v, o);
    return v;
}

namespace pg8 {
constexpr int BM = 256, BK = 64, HALF = 128, HTB = HALF * BK * 2, STAGE_BYTES = 8 * HTB, NXCD = 8, WGM = 8;
__host__ __device__ __forceinline__ int lds_byte(int r, int c) { const int st = (r >> 4) * 2 + (c >> 5), rr = r & 15, cc = c & 31, ob = rr * 64 + cc * 2; return st * 1024 + (ob ^ (((ob >> 9) & 1) << 5)); }
__host__ __device__ __forceinline__ void stage_rc(int b, int& R, int& C) { const int st = b / 1024, sb = b % 1024, swz = sb ^ (((sb >> 9) & 1) << 5); R = (st >> 1) * 16 + swz / 64; C = (st & 1) * 32 + (swz % 64) / 2; }
__host__ __device__ __forceinline__ int perm32(int rho) { const int n = rho >> 4, i = rho & 15; return 8 * (i >> 2) + 4 * n + (i & 3); }
struct Unit { int pm, pn, idx; };
struct Gemm { const bf16_t* A; const bf16_t* Bt; int lda, ldb, K; };
struct StaticOrder {
    int nM, nN, nwg, G, c;
    __host__ __device__ void init(int M, int N, int G_, int c_) { nM = M / BM; nN = N / BM; nwg = nM * nN; G = G_; c = c_; }
    __host__ __device__ bool next(int i, Unit& u) const {
        const long L = (long)i * G + c; if (L >= nwg) return false;
        int wgid = (int)L; { const int q = nwg / NXCD, r = nwg % NXCD, xcd = wgid % NXCD, off = wgid / NXCD; wgid = (xcd < r ? xcd * (q + 1) : r * (q + 1) + (xcd - r) * q) + off; }
        const int nig = WGM * nN, gid = wgid / nig, fm = gid * WGM, gsz = (nM - fm) < WGM ? (nM - fm) : WGM;
        u.pm = fm + ((wgid % nig) % gsz); u.pn = (wgid % nig) / gsz; u.idx = i; return true;
    }
    __device__ __forceinline__ void a_ready(const Unit&) const {}
    __device__ __forceinline__ void done(const Unit&) const {}
};
template <class Epi, class Sched, bool ALIGN_EPI = false, bool SP2 = false>
__device__ __forceinline__ void gemm_phase(PG8_LAS unsigned char* lds, const Gemm g, const Sched& S, const Epi& E) {
    int tid_ = threadIdx.x; asm volatile("" : "+v"(tid_));
    const int tid = tid_, wid = __builtin_amdgcn_readfirstlane(tid >> 6), lane = tid & 63, wr = wid >> 2, wc = wid & 3, fr = lane & 15, fq = lane >> 4;
    const int K = g.K, nt = K / BK;
    unsigned voffA[2], voffB[2];
#pragma unroll
    for (int i = 0; i < 2; ++i) { int R, C; stage_rc(tid * 16 + i * 8192, R, C); const int Rb = Epi::PERM ? ((R & ~31) + perm32(R & 31)) : R;
        voffA[i] = (unsigned)(R * g.lda + C) * 2u; voffB[i] = (unsigned)(Rb * g.ldb + C) * 2u; }
    const size_t kstep = (size_t)(BK * 2);
    const size_t hstepA = (size_t)HALF * g.lda * 2, hstepB = (size_t)HALF * g.ldb * 2;
    const size_t tstepA = 2 * hstepA, tstepB = 2 * hstepB;
    const unsigned ldsw = (unsigned)wid * 1024u;
    const int aoff = lds_byte(wr * 64 + fr, fq * 8), boff = lds_byte(wc * 32 + fr, fq * 8);
#define PG8_SA(b, h) (((b) * 2 + (h)) * HTB)
#define PG8_SB(b, h) ((4 + (b) * 2 + (h)) * HTB)
#define PG8_STAGE(bufoff, gbase, voff) do { _Pragma("unroll") for (int _i = 0; _i < 2; ++_i) \
        __builtin_amdgcn_global_load_lds((const unsigned*)((const char*)(gbase) + (voff)[_i]), (PG8_LAS unsigned*)(lds + (bufoff) + ldsw + _i * 8192), 16, 0, 0); } while (0)
#define PG8_LDA(dst, b, h) do { _Pragma("unroll") for (int m = 0; m < 4; ++m) _Pragma("unroll") for (int k = 0; k < 2; ++k) dst[m][k] = *(const PG8_LAS bf16x8*)(lds + PG8_SA(b, h) + aoff + m * 2048 + k * 1024); } while (0)
#define PG8_LDB(dst, b, h) do { _Pragma("unroll") for (int n = 0; n < 2; ++n) _Pragma("unroll") for (int k = 0; k < 2; ++k) dst[n][k] = *(const PG8_LAS bf16x8*)(lds + PG8_SB(b, h) + boff + n * 2048 + k * 1024); } while (0)
#define PG8_MMA(ai, bj, At, Bt) do { __builtin_amdgcn_s_setprio(1); _Pragma("unroll") for (int m = 0; m < 4; ++m) _Pragma("unroll") for (int n = 0; n < 2; ++n) _Pragma("unroll") for (int k = 0; k < 2; ++k) \
        acc[ai][bj][m][n] = __builtin_amdgcn_mfma_f32_16x16x32_bf16(Bt[n][k], At[m][k], acc[ai][bj][m][n], 0, 0, 0); __builtin_amdgcn_s_setprio(0); } while (0)
#define PG8_WAIT_V(n) asm volatile("s_waitcnt vmcnt(" #n ")" ::: "memory")
#define PG8_WAIT_L(n) asm volatile("s_waitcnt lgkmcnt(" #n ")" ::: "memory")
#define PG8_BAR __builtin_amdgcn_s_barrier()
#define PG8_SCHED __builtin_amdgcn_sched_barrier(0)
    Unit cur, nxt; int ui = 0;
    if (!S.next(0, cur)) return;
    f32x4 acc[2][2][4][2];
#pragma unroll
    for (int a = 0; a < 2; ++a)
#pragma unroll
        for (int b = 0; b < 2; ++b)
#pragma unroll
            for (int m = 0; m < 4; ++m)
#pragma unroll
                for (int n = 0; n < 2; ++n) acc[a][b][m][n] = (f32x4){0.f, 0.f, 0.f, 0.f};
    bf16x8 At[4][2], B0[2][2], B1[2][2];
    const char* cA = (const char*)g.A + (size_t)cur.pm * tstepA; const char* cB = (const char*)g.Bt + (size_t)cur.pn * tstepB;
    S.a_ready(cur);
    if constexpr (SP2) {
        PG8_STAGE(PG8_SB(0, 0), cB, voffB); PG8_STAGE(PG8_SB(0, 1), cB + hstepB, voffB); PG8_STAGE(PG8_SA(0, 0), cA, voffA); PG8_STAGE(PG8_SA(0, 1), cA + hstepA, voffA);
        if (wr == 1) PG8_BAR;
        PG8_WAIT_V(2); PG8_BAR;
        PG8_STAGE(PG8_SB(1, 0), cB + kstep, voffB); PG8_STAGE(PG8_SA(1, 0), cA + kstep, voffA); PG8_STAGE(PG8_SB(1, 1), cB + hstepB + kstep, voffB);
        PG8_WAIT_V(6); PG8_BAR;
    } else {
        PG8_STAGE(PG8_SB(0, 0), cB, voffB); PG8_STAGE(PG8_SA(0, 0), cA, voffA); PG8_STAGE(PG8_SB(0, 1), cB + hstepB, voffB); PG8_STAGE(PG8_SA(0, 1), cA + hstepA, voffA);
        if (wr == 1) PG8_BAR;
        PG8_WAIT_V(4); PG8_BAR;
        PG8_STAGE(PG8_SB(1, 0), cB + kstep, voffB); PG8_STAGE(PG8_SA(1, 0), cA + kstep, voffA); PG8_STAGE(PG8_SB(1, 1), cB + hstepB + kstep, voffB);
        PG8_WAIT_V(6); PG8_BAR;
    }
    for (;;) {
        const bool has_next = S.next(ui + 1, nxt);
        const char* nA = has_next ? (const char*)g.A + (size_t)nxt.pm * tstepA : cA; const char* nB = has_next ? (const char*)g.Bt + (size_t)nxt.pn * tstepB : cB;
        for (int t = 0; t < nt; t += 2) {
            const bool last = (t == nt - 2);
            const char* a1 = cA + (size_t)(t + 1) * kstep;
            const char* a2 = last ? nA : cA + (size_t)(t + 2) * kstep; const char* b2 = last ? nB : cB + (size_t)(t + 2) * kstep;
            const char* a3 = a2 + kstep; const char* b3 = b2 + kstep;
            if (last && has_next) S.a_ready(nxt);
            if constexpr (Epi::SEG) { if (t != 0 && (t & 7) == 0) E.rescale(acc, cur, t >> 3, wr, wc, fr, fq); }
            if constexpr (SP2) {
            PG8_LDB(B0, 0, 0); PG8_LDB(B1, 0, 1); PG8_SCHED; PG8_LDA(At, 0, 0); PG8_STAGE(PG8_SA(1, 1), a1 + hstepA, voffA);
            PG8_WAIT_V(8); PG8_WAIT_L(0); PG8_BAR; PG8_MMA(0, 0, At, B0); PG8_MMA(0, 1, At, B1); PG8_BAR; PG8_SCHED;
            PG8_LDA(At, 0, 1); PG8_STAGE(PG8_SB(0, 0), b2, voffB); PG8_STAGE(PG8_SB(0, 1), b2 + hstepB, voffB); PG8_STAGE(PG8_SA(0, 0), a2, voffA);
            PG8_WAIT_V(8); PG8_WAIT_L(0); PG8_BAR; PG8_MMA(1, 0, At, B0); PG8_MMA(1, 1, At, B1); PG8_BAR; PG8_SCHED;
            PG8_LDB(B0, 1, 0); PG8_LDB(B1, 1, 1); PG8_SCHED; PG8_LDA(At, 1, 0); PG8_STAGE(PG8_SA(0, 1), a2 + hstepA, voffA);
            PG8_WAIT_V(8); PG8_WAIT_L(0); PG8_BAR; PG8_MMA(0, 0, At, B0); PG8_MMA(0, 1, At, B1); PG8_BAR; PG8_SCHED;
            PG8_LDA(At, 1, 1); PG8_STAGE(PG8_SB(1, 0), b3, voffB); PG8_STAGE(PG8_SB(1, 1), b3 + hstepB, voffB); PG8_STAGE(PG8_SA(1, 0), a3, voffA);
            PG8_WAIT_V(8); PG8_WAIT_L(0); PG8_BAR; PG8_MMA(1, 0, At, B0); PG8_MMA(1, 1, At, B1); PG8_BAR; PG8_SCHED;
            } else {
            PG8_LDB(B0, 0, 0); PG8_SCHED; PG8_LDA(At, 0, 0); PG8_STAGE(PG8_SA(1, 1), a1 + hstepA, voffA);
            PG8_WAIT_L(8); PG8_BAR; PG8_WAIT_L(0); PG8_MMA(0, 0, At, B0); PG8_BAR; PG8_SCHED;
            PG8_LDB(B1, 0, 1); PG8_STAGE(PG8_SB(0, 0), b2, voffB);
            PG8_BAR; PG8_WAIT_L(0); PG8_MMA(0, 1, At, B1); PG8_BAR;
            PG8_LDA(At, 0, 1); PG8_STAGE(PG8_SA(0, 0), a2, voffA);
            PG8_BAR; PG8_WAIT_L(0); PG8_MMA(1, 0, At, B0); PG8_BAR; PG8_SCHED;
            PG8_STAGE(PG8_SB(0, 1), b2 + hstepB, voffB);
            PG8_WAIT_V(6); PG8_BAR; PG8_MMA(1, 1, At, B1); PG8_BAR;
            PG8_LDB(B0, 1, 0); PG8_SCHED; PG8_LDA(At, 1, 0); PG8_STAGE(PG8_SA(0, 1), a2 + hstepA, voffA);
            PG8_WAIT_L(8); PG8_BAR; PG8_WAIT_L(0); PG8_MMA(0, 0, At, B0); PG8_BAR; PG8_SCHED;
            PG8_LDB(B1, 1, 1); PG8_STAGE(PG8_SB(1, 0), b3, voffB);
            PG8_BAR; PG8_WAIT_L(0); PG8_MMA(0, 1, At, B1); PG8_BAR;
            PG8_LDA(At, 1, 1); PG8_STAGE(PG8_SA(1, 0), a3, voffA);
            PG8_BAR; PG8_WAIT_L(0); PG8_MMA(1, 0, At, B0); PG8_BAR; PG8_SCHED;
            PG8_STAGE(PG8_SB(1, 1), b3 + hstepB, voffB);
            PG8_WAIT_V(6); PG8_BAR; PG8_MMA(1, 1, At, B1); PG8_BAR;
            }
        }
        if constexpr (ALIGN_EPI) { if (wr == 0) PG8_BAR; }
        if constexpr (!Epi::AFTER_DRAIN) { E(acc, cur, wr, wc, fr, fq); S.done(cur); }
        if (!has_next) break;
#pragma unroll
        for (int a = 0; a < 2; ++a)
#pragma unroll
            for (int b = 0; b < 2; ++b)
#pragma unroll
                for (int m = 0; m < 4; ++m)
#pragma unroll
                    for (int n = 0; n < 2; ++n) acc[a][b][m][n] = (f32x4){0.f, 0.f, 0.f, 0.f};
        cur = nxt; cA = nA; cB = nB; ++ui;
        if constexpr (ALIGN_EPI) { if (wr == 1) PG8_BAR; }
    }
    PG8_WAIT_V(0);
    if constexpr (!ALIGN_EPI) { if (wr == 0) PG8_BAR; }
    PG8_BAR;
    if constexpr (Epi::AFTER_DRAIN) { E.fused(acc, cur, wr, wc, fr, fq, lds, wid, lane); S.done(cur); }
#undef PG8_SA
#undef PG8_SB
#undef PG8_STAGE
#undef PG8_LDA
#undef PG8_LDB
#undef PG8_MMA
#undef PG8_WAIT_V
#undef PG8_WAIT_L
#undef PG8_BAR
#undef PG8_SCHED
}
}

#ifndef PG8_SP2
#define PG8_SP2 true
#endif
#ifndef PG8_ALIGN
#define PG8_ALIGN true
#endif

using pg8::Unit; using pg8::BM; using pg8::HALF;

__device__ __forceinline__ float hsum4(const f32x4 a) { return (a[0] + a[1]) + (a[2] + a[3]); }
__device__ __forceinline__ float hsq4(const f32x4 a) { return (a[0] * a[0] + a[1] * a[1]) + (a[2] * a[2] + a[3] * a[3]); }
__device__ __forceinline__ float rstd16(const float* p, float invn) {
    const f32x4 a = *(const f32x4*)p, b = *(const f32x4*)(p + 4), c = *(const f32x4*)(p + 8), d = *(const f32x4*)(p + 12);
    return __builtin_amdgcn_rsqf(((hsum4(a) + hsum4(b)) + (hsum4(c) + hsum4(d))) * invn + EPS);
}
__device__ __forceinline__ u32x4 pack8(const f32x4 v0, const f32x4 v1) { u32x4 w; w.x = cvt_pk_bf16(v0[0], v0[1]); w.y = cvt_pk_bf16(v0[2], v0[3]); w.z = cvt_pk_bf16(v1[0], v1[1]); w.w = cvt_pk_bf16(v1[2], v1[3]); return w; }
__device__ __forceinline__ void unpack8(const u32x4 w, float (&e)[8]) { e[0] = bflo(w.x); e[1] = bfhi(w.x); e[2] = bflo(w.y); e[3] = bfhi(w.y); e[4] = bflo(w.z); e[5] = bfhi(w.z); e[6] = bflo(w.w); e[7] = bfhi(w.w); }
__device__ __forceinline__ float quad_reduce(float s) { s += __shfl_xor(s, 16); s += __shfl_xor(s, 32); return s; }

__device__ __forceinline__ int p16(int x) { return (x & 3) + 4 * ((x >> 3) & 1) + 8 * ((x >> 2) & 1); }

constexpr int SPARE_OFF = 131072, BL_OFF = SPARE_OFF + 8192, XST_OFF = 147440;
__device__ __forceinline__ void fill_rs_table(LAS unsigned char* lds, const float* ssq, const pg8::StaticOrder& S) {
    int tid_ = threadIdx.x; asm volatile("" : "+v"(tid_));
    LAS float* rsl = (LAS float*)(lds + SPARE_OFF);
#pragma unroll
    for (int k = 0; k < 6; ++k) {
        const int gi = tid_ + 512 * k, i = gi >> 8, row = gi & 255; pg8::Unit u; const bool ok = S.next(i, u); const int pm = ok ? u.pm : 0;
        const float rs = rstd16(ssq + (size_t)(pm * BM + row) * 16, 1.0f / 1024.0f);
        if (ok) rsl[gi] = rs;
    }
}
__device__ __forceinline__ void fill_gate_bias(LAS unsigned char* lds, const float* bgate, const pg8::StaticOrder& S) {
    int tid_ = threadIdx.x; asm volatile("" : "+v"(tid_));
    LAS float* bl = (LAS float*)(lds + BL_OFF);
#pragma unroll
    for (int k = 0; k < 4; ++k) {
        const int gi = tid_ + 512 * k, i = gi >> 8, c = gi & 255; pg8::Unit u; const bool ok = S.next(i, u); const int pn = ok ? u.pn : 0;
        const float v = bgate[(pn >> 2) * 1024 + (pn & 3) * 256 + c];
        if (ok) bl[gi] = v;
    }
}
struct EpiInA {
    static constexpr bool PERM = true, AFTER_DRAIN = false, SEG = false;
    static constexpr int TABLES = 1;
    const float* ssq; const LAS float* rsl; bf16_t* projb; bf16_t* cq; bf16_t* ckv; float* ssqq; float* ssqkv;
    const float* trc; const float* trs; const float* tmc; const float* tms; bf16_t* rvt; bf16_t* rkt; bf16_t* rq;
    template <int T> __device__ __forceinline__ void run(const f32x4 (&acc)[2][2][4][2], const Unit& u, int wr, int wc, int fr, int fq, int colbase, float sc, bf16_t* proj, const int LDP) const {
        const int lc0 = wc * 32 + 8 * fq;
        int rl0 = wr * 64 + fr; asm volatile("" : "+v"(rl0));
        const int rowbase = u.pm * BM + rl0; const LAS float* rsu = rsl + u.idx * 256 + rl0;
        int fqo = fq; asm volatile("" : "+v"(fqo));
#pragma unroll
        for (int ai = 0; ai < 2; ++ai)
#pragma unroll
            for (int m = 0; m < 4; ++m) {
                const int row = rowbase + ai * HALF + m * 16;
                const float rs = rsu[ai * HALF + m * 16] * sc;
                f32x4 v[2][2];
#pragma unroll
                for (int bj = 0; bj < 2; ++bj)
#pragma unroll
                    for (int n = 0; n < 2; ++n) v[bj][n] = acc[ai][bj][m][n] * rs;
                if constexpr (T == 8) {
                    const int bb = row >> 11, t = row & (SEQ - 1), tpos = (t & ~15) + p16(t & 15);
#pragma unroll
                    for (int bj = 0; bj < 2; ++bj) { const int vi = colbase + bj * HALF + lc0;
                        bf16_t* dst = rvt + ((size_t)bb * 512 + vi) * SEQ + tpos;
#pragma unroll
                        for (int j = 0; j < 4; ++j) { dst[(size_t)j * SEQ] = (bf16_t)f2bf(v[bj][0][j]); dst[(size_t)(4 + j) * SEQ] = (bf16_t)f2bf(v[bj][1][j]); } }
                } else if constexpr (T == 0 || T == 1 || T == 2) {
                    bf16_t* dst = proj + (size_t)row * LDP + colbase + lc0;
#pragma unroll
                    for (int bj = 0; bj < 2; ++bj) {
                        f32x4 a = v[bj][0], b = v[bj][1];
                        if constexpr (T == 1) { a = silu4(a); b = silu4(b); }
                        if constexpr (T == 2) { a = gelu4(a); b = gelu4(b); }
                        *(u32x4*)(dst + bj * HALF) = pack8(a, b);
                    }
                } else if constexpr (T == 3) {
                    bf16_t* dst = proj + (size_t)row * LDP + colbase + (lc0 >> 1);
#pragma unroll
                    for (int bj = 0; bj < 2; ++bj) { const f32x4 o = v[bj][0] * v[bj][1]; u32x2 w; w.x = cvt_pk_bf16(o[0], o[1]); w.y = cvt_pk_bf16(o[2], o[3]); *(u32x2*)(dst + bj * 64) = w; }
                } else if constexpr (T == 4 || T == 9) {
                    const int q = (wc & 1) * 4 + fqo;
                    const f32x4 c = *(const f32x4*)(trc + (size_t)row * 32 + 4 * q), s = *(const f32x4*)(trs + (size_t)row * 32 + 4 * q);
                    bf16_t* dst = proj + (size_t)row * LDP + colbase + lc0;
#pragma unroll
                    for (int bj = 0; bj < 2; ++bj) { const f32x4 x1 = v[bj][0], x2 = v[bj][1]; const f32x4 o1 = x1 * c - x2 * s, o2 = x1 * s + x2 * c; *(u32x4*)(dst + bj * HALF) = pack8(o1, o2);
                        if constexpr (T == 9) {
                            const int bb = row >> 11, t = row & (SEQ - 1), tpos = (t & ~15) + p16(t & 15), hd = bj * 2 + (wc >> 1);
                            const float dec = fast_exp2((float)(127 - (t & 127)) * __log2f(1.0f - exp2f(-(float)(5 + hd))));
                            bf16_t* kd = rkt + ((size_t)bb * 256 + bj * HALF + lc0) * SEQ + tpos;
#pragma unroll
                            for (int j = 0; j < 4; ++j) { kd[(size_t)j * SEQ] = (bf16_t)f2bf(o1[j] * dec); kd[(size_t)(4 + j) * SEQ] = (bf16_t)f2bf(o2[j] * dec); } } }
                } else if constexpr (T == 5) {
                    bf16_t* dst = cq + (size_t)row * 512 + lc0;
                    float s = 0.f;
#pragma unroll
                    for (int bj = 0; bj < 2; ++bj) { *(u32x4*)(dst + bj * HALF) = pack8(v[bj][0], v[bj][1]); s += hsq4(v[bj][0]) + hsq4(v[bj][1]); }
                    s = quad_reduce(s);
                    if (fq == 0) ssqq[(size_t)row * 8 + wc] = s;
                } else if constexpr (T == 6) {
                    bf16_t* dst = cq + (size_t)row * 512 + 256 + lc0;
                    *(u32x4*)dst = pack8(v[0][0], v[0][1]);
                    float s = quad_reduce(hsq4(v[0][0]) + hsq4(v[0][1]));
                    if (fq == 0) ssqq[(size_t)row * 8 + 4 + wc] = s;
                    if (wc == 0) {
                        const f32x4 c = *(const f32x4*)(tmc + (size_t)row * 16 + 4 * fqo), sn = *(const f32x4*)(tms + (size_t)row * 16 + 4 * fqo);
                        const f32x4 x1 = v[1][0], x2 = v[1][1];
                        *(u32x4*)(dst + HALF) = pack8(x1 * c - x2 * sn, x1 * sn + x2 * c);
                    } else { *(u32x4*)(dst + HALF) = (u32x4){0u, 0u, 0u, 0u}; }
                } else {
                    bf16_t* dst = ckv + (size_t)row * 256 + lc0;
                    float s = 0.f;
#pragma unroll
                    for (int bj = 0; bj < 2; ++bj) { *(u32x4*)(dst + bj * HALF) = pack8(v[bj][0], v[bj][1]); s += hsq4(v[bj][0]) + hsq4(v[bj][1]); }
                    s = quad_reduce(s);
                    if (fq == 0) ssqkv[(size_t)row * 4 + wc] = s;
                }
                asm volatile("" ::: "memory");
            }
    }
    __device__ __forceinline__ void operator()(const f32x4 (&acc)[2][2][4][2], const Unit& u, int wr, int wc, int fr, int fq) const {
        const int pn = u.pn;
        if (pn < 2) run<0>(acc, u, wr, wc, fr, fq, PC_AB + 256 * pn, 1.f, projb, ::LDP);
        else if (pn < 6) run<3>(acc, u, wr, wc, fr, fq, PC_CX + 128 * (pn - 2), 1.f, projb, ::LDP);
        else if (pn == 6) run<4>(acc, u, wr, wc, fr, fq, 0, 1.f, rq, 1024);
        else if (pn == 7) run<9>(acc, u, wr, wc, fr, fq, 256, 0.125f, rq, 1024);
        else if (pn < 10) run<8>(acc, u, wr, wc, fr, fq, 256 * (pn - 8), 1.f, projb, ::LDP);
        else if (pn < 12) run<1>(acc, u, wr, wc, fr, fq, 512 + 256 * (pn - 10), 1.f, rq, 1024);
        else if (pn < 16) run<2>(acc, u, wr, wc, fr, fq, PC_SU + 256 * (pn - 12), 1.f, projb, ::LDP);
        else if (pn == 16) run<5>(acc, u, wr, wc, fr, fq, 0, 1.f, projb, ::LDP);
        else if (pn == 17) run<6>(acc, u, wr, wc, fr, fq, 0, 1.f, projb, ::LDP);
        else run<7>(acc, u, wr, wc, fr, fq, 0, 1.f, projb, ::LDP);
    }
};

struct EpiGate {
    static constexpr bool PERM = true, AFTER_DRAIN = false, SEG = false;
    static constexpr int TABLES = 2;
    const float* ssq; const float* bgate; const LAS float* rsl; const LAS float* bl; bf16_t* G;
    __device__ __forceinline__ void operator()(const f32x4 (&acc)[2][2][4][2], const Unit& u, int wr, int wc, int fr, int fq) const {
        const int lc0 = wc * 32 + 8 * fq, br = u.pn >> 2, cb = (u.pn & 3) * 256 + lc0;
        int rl0 = wr * 64 + fr; asm volatile("" : "+v"(rl0));
        const int rowbase = u.pm * BM + rl0; const LAS float* rsu = rsl + u.idx * 256 + rl0;
        f32x4 bv[2][2];
#pragma unroll
        for (int bj = 0; bj < 2; ++bj)
#pragma unroll
            for (int n = 0; n < 2; ++n) bv[bj][n] = *(const LAS f32x4*)(bl + u.idx * 256 + lc0 + bj * HALF + 4 * n);
#pragma unroll
        for (int ai = 0; ai < 2; ++ai)
#pragma unroll
            for (int m = 0; m < 4; ++m) {
                const int row = rowbase + ai * HALF + m * 16;
                const float rs = rsu[ai * HALF + m * 16];
                bf16_t* dst = G + ((size_t)br * MH + row) * 1024 + cb;
#pragma unroll
                for (int bj = 0; bj < 2; ++bj) {
                    f32x4 a = acc[ai][bj][m][0] * rs + bv[bj][0], b = acc[ai][bj][m][1] * rs + bv[bj][1];
                    a = sigmoid4(a); b = sigmoid4(b);
#pragma unroll
                    for (int j = 0; j < 4; ++j) { a[j] = fmaxf(a[j], 1e-20f); b[j] = fmaxf(b[j], 1e-20f); }
                    *(u32x4*)(dst + bj * HALF) = pack8(a, b);
                }
            }
    }
};

struct EpiUpQ {
    static constexpr int TABLES = 0;
    static constexpr bool PERM = true, AFTER_DRAIN = false, SEG = false;
    const float* ssqq; const float* tmc; const float* tms; bf16_t* Q;
    __device__ __forceinline__ void operator()(const f32x4 (&acc)[2][2][4][2], const Unit& u, int wr, int wc, int fr, int fq) const {
        const int lc0 = wc * 32 + 8 * fq;
        int rowbase = u.pm * BM + wr * 64 + fr; asm volatile("" : "+v"(rowbase));
        bool isr[2]; int idx[2];
#pragma unroll
        for (int bj = 0; bj < 2; ++bj) { const int c8 = 256 * u.pn + bj * HALF + lc0, r96 = c8 % 96; isr[bj] = r96 >= 64; idx[bj] = isr[bj] ? ((r96 - 64) >> 3) * 4 : 0; }
#pragma unroll
        for (int ai = 0; ai < 2; ++ai)
#pragma unroll
            for (int m = 0; m < 4; ++m) {
                const int row = rowbase + ai * HALF + m * 16;
                const f32x4 s0 = *(const f32x4*)(ssqq + (size_t)row * 8), s1 = *(const f32x4*)(ssqq + (size_t)row * 8 + 4);
                const float rs = __builtin_amdgcn_rsqf((hsum4(s0) + hsum4(s1)) * (1.0f / 384.0f) + EPS) * QSCALE;
                bf16_t* dst = Q + (size_t)row * 768 + 256 * u.pn + lc0;
#pragma unroll
                for (int bj = 0; bj < 2; ++bj) {
                    const f32x4 x1 = acc[ai][bj][m][0] * rs, x2 = acc[ai][bj][m][1] * rs;
                    const f32x4 c = *(const f32x4*)(tmc + (size_t)row * 16 + idx[bj]), s = *(const f32x4*)(tms + (size_t)row * 16 + idx[bj]);
                    f32x4 o1 = x1 * c - x2 * s, o2 = x1 * s + x2 * c;
                    if (!isr[bj]) { o1 = x1; o2 = x2; }
                    *(u32x4*)(dst + bj * HALF) = pack8(o1, o2);
                }
                asm volatile("" ::: "memory");
            }
    }
};

struct EpiUpKV {
    static constexpr int TABLES = 0;
    static constexpr bool PERM = true, AFTER_DRAIN = false, SEG = false;
    const float* ssqkv; bf16_t* KV; bf16_t* VT;
    __device__ __forceinline__ void operator()(const f32x4 (&acc)[2][2][4][2], const Unit& u, int wr, int wc, int fr, int fq) const {
        const int lc0 = wc * 32 + 8 * fq;
        int rowbase = u.pm * BM + wr * 64 + fr; asm volatile("" : "+v"(rowbase));
#pragma unroll
        for (int ai = 0; ai < 2; ++ai)
#pragma unroll
            for (int m = 0; m < 4; ++m) {
                const int row = rowbase + ai * HALF + m * 16;
                const f32x4 s0 = *(const f32x4*)(ssqkv + (size_t)row * 4);
                const float rs = __builtin_amdgcn_rsqf(hsum4(s0) * (1.0f / 256.0f) + EPS);
                if (u.pn < 2) {
                    bf16_t* dst = KV + (size_t)row * 512 + 256 * u.pn + lc0;
#pragma unroll
                    for (int bj = 0; bj < 2; ++bj) *(u32x4*)(dst + bj * HALF) = pack8(acc[ai][bj][m][0] * rs, acc[ai][bj][m][1] * rs);
                } else {
                    const int bb = row >> 11, t = row & (SEQ - 1), tpos = (t & ~15) + p16(t & 15);
#pragma unroll
                    for (int bj = 0; bj < 2; ++bj) { const int vi = 256 * (u.pn - 2) + bj * HALF + lc0;
                        bf16_t* dst = VT + ((size_t)bb * 512 + vi) * SEQ + tpos;
#pragma unroll
                        for (int j = 0; j < 4; ++j) { dst[(size_t)j * SEQ] = (bf16_t)f2bf(acc[ai][bj][m][0][j] * rs); dst[(size_t)(4 + j) * SEQ] = (bf16_t)f2bf(acc[ai][bj][m][1][j] * rs); } }
                }
                asm volatile("" ::: "memory");
            }
    }
};

struct EpiMerged {
    static constexpr int TABLES = 0;
    static constexpr bool PERM = true, AFTER_DRAIN = false, SEG = true;
    const bf16_t* G; bf16_t* out;
    __device__ __forceinline__ void rescale(f32x4 (&acc)[2][2][4][2], const Unit& u, int seg, int wr, int wc, int fr, int fq) const {
        const int lc0 = wc * 32 + 8 * fq;
        int rowbase = u.pm * BM + wr * 64 + fr; asm volatile("" : "+v"(rowbase));
#pragma unroll
        for (int ai = 0; ai < 2; ++ai)
#pragma unroll
            for (int m = 0; m < 4; ++m) {
                const int row = rowbase + ai * HALF + m * 16;
                const bf16_t* g0 = G + ((size_t)(seg - 1) * MH + row) * 1024 + 256 * u.pn + lc0;
                const bf16_t* g1 = g0 + (size_t)MH * 1024;
#pragma unroll
                for (int bj = 0; bj < 2; ++bj) {
                    float a[8], b[8]; unpack8(*(const u32x4*)(g0 + bj * HALF), a); unpack8(*(const u32x4*)(g1 + bj * HALF), b);
#pragma unroll
                    for (int j = 0; j < 4; ++j) { acc[ai][bj][m][0][j] *= a[j] * fast_rcp(b[j]); acc[ai][bj][m][1][j] *= a[4 + j] * fast_rcp(b[4 + j]); }
                }
            }
    }
    __device__ __forceinline__ void operator()(const f32x4 (&acc)[2][2][4][2], const Unit& u, int wr, int wc, int fr, int fq) const {
        const int lc0 = wc * 32 + 8 * fq;
        int rowbase = u.pm * BM + wr * 64 + fr; asm volatile("" : "+v"(rowbase));
#pragma unroll
        for (int ai = 0; ai < 2; ++ai)
#pragma unroll
            for (int m = 0; m < 4; ++m) {
                const int row = rowbase + ai * HALF + m * 16;
                const bf16_t* g3 = G + ((size_t)3 * MH + row) * 1024 + 256 * u.pn + lc0;
                bf16_t* dst = out + (size_t)row * 1024 + 256 * u.pn + lc0;
#pragma unroll
                for (int bj = 0; bj < 2; ++bj) {
                    float a[8]; unpack8(*(const u32x4*)(g3 + bj * HALF), a);
                    f32x4 o0 = acc[ai][bj][m][0], o1 = acc[ai][bj][m][1];
#pragma unroll
                    for (int j = 0; j < 4; ++j) { o0[j] *= a[j]; o1[j] *= a[4 + j]; }
                    *(u32x4*)(dst + bj * HALF) = pack8(o0, o1);
                }
            }
    }
};

template <bool F32IN, bool F32OUT> struct EpiRes {
    static constexpr int TABLES = 0;
    static constexpr bool PERM = true, AFTER_DRAIN = false, SEG = false;
    const float* xres; float* xout; bf16_t* xb; float* ssq;
    __device__ __forceinline__ void operator()(const f32x4 (&acc)[2][2][4][2], const Unit& u, int wr, int wc, int fr, int fq) const {
        const int lc0 = wc * 32 + 8 * fq;
        int rowbase = u.pm * BM + wr * 64 + fr; asm volatile("" : "+v"(rowbase));
#pragma unroll
        for (int ai = 0; ai < 2; ++ai)
#pragma unroll
            for (int m = 0; m < 4; ++m) {
                const int row = rowbase + ai * HALF + m * 16;
                const size_t off = (size_t)row * 1024 + 256 * u.pn + lc0;
                float s = 0.f;
#pragma unroll
                for (int bj = 0; bj < 2; ++bj) {
                    f32x4 r0, r1;
                    if constexpr (F32IN) { r0 = *(const f32x4*)(xres + off + bj * HALF); r1 = *(const f32x4*)(xres + off + bj * HALF + 4); }
                    else { float e[8]; unpack8(*(const u32x4*)(xb + off + bj * HALF), e); r0 = (f32x4){e[0], e[1], e[2], e[3]}; r1 = (f32x4){e[4], e[5], e[6], e[7]}; }
                    const f32x4 o0 = r0 + acc[ai][bj][m][0], o1 = r1 + acc[ai][bj][m][1];
                    if constexpr (F32OUT) { *(f32x4*)(xout + off + bj * HALF) = o0; *(f32x4*)(xout + off + bj * HALF + 4) = o1; }
                    else *(u32x4*)(xb + off + bj * HALF) = pack8(o0, o1);
                    s += hsq4(o0) + hsq4(o1);
                }
                s = quad_reduce(s);
                if (fq == 0) ssq[(size_t)row * 16 + u.pn * 4 + wc] = s;
                asm volatile("" ::: "memory");
            }
    }
};

struct EpiFfnIn {
    static constexpr bool PERM = true, AFTER_DRAIN = false, SEG = false;
    static constexpr int TABLES = 1;
    const float* ssq; const LAS float* rsl; bf16_t* act;
    __device__ __forceinline__ void operator()(const f32x4 (&acc)[2][2][4][2], const Unit& u, int wr, int wc, int fr, int fq) const {
        const int lc0 = wc * 32 + 8 * fq;
        int rl0 = wr * 64 + fr; asm volatile("" : "+v"(rl0));
        const int rowbase = u.pm * BM + rl0; const LAS float* rsu = rsl + u.idx * 256 + rl0;
#pragma unroll
        for (int ai = 0; ai < 2; ++ai)
#pragma unroll
            for (int m = 0; m < 4; ++m) {
                const int row = rowbase + ai * HALF + m * 16;
                const float rs = rsu[ai * HALF + m * 16];
                bf16_t* dst = act + (size_t)row * DFF + 128 * u.pn + (lc0 >> 1);
#pragma unroll
                for (int bj = 0; bj < 2; ++bj) {
                    const f32x4 g = acc[ai][bj][m][0] * rs, uu = acc[ai][bj][m][1] * rs; const f32x4 o = silu4(g) * uu;
                    u32x2 w; w.x = cvt_pk_bf16(o[0], o[1]); w.y = cvt_pk_bf16(o[2], o[3]); *(u32x2*)(dst + bj * 64) = w;
                }
            }
    }
};

template <class Epi> __device__ __forceinline__ void run_gemm(LAS unsigned char* lds, const bf16_t* A, int lda, const bf16_t* Bt, int ldb, int K, int N, const Epi& E, int M = MH) {
    asm volatile("" : "+s"(lda), "+s"(ldb), "+s"(K), "+s"(N), "+s"(M));
    pg8::Gemm g{A, Bt, lda, ldb, K}; pg8::StaticOrder S; S.init(M, N, (int)gridDim.x, (int)blockIdx.x);
    if constexpr (Epi::TABLES >= 1) { fill_rs_table(lds, E.ssq, S); if constexpr (Epi::TABLES == 2) fill_gate_bias(lds, E.bgate, S); __syncthreads(); }
    pg8::gemm_phase<Epi, pg8::StaticOrder, true, true>(lds, g, S, E);
}

enum { MAP_NAT = 0, MAP_INA = 1, MAP_GATE = 2, MAP_UQ = 3, MAP_UKV = 4, MAP_FI = 5 };
__device__ __forceinline__ int pair8(int p, int half) { const int q = p >> 3, j = p & 7; return (j < 4) ? (4 * q + j) : (half + 4 * q + (j - 4)); }
__device__ __forceinline__ int map_col(int id, int n) {
    switch (id) {
    case MAP_INA:
        if (n < 512) return n;
        if (n < 1536) { const int c = n - 512, q = c >> 3, j = c & 7; return (j < 4) ? (512 + 4 * q + j) : (1024 + 4 * q + (j - 4)); }
        if (n < 2048) { const int c = n - 1536, base = (c >> 8) ? 1792 : 1536, cc = c & 255, h = cc >> 6; return base + 64 * h + pair8(cc & 63, 32); }
        if (n < 4096) return n;
        if (n < 4608) { const int c = n - 4096; if (c < 384) return 4096 + c; if (c < 416) return 4736 + pair8(c - 384, 16); return -1; }
        return 4480 + (n - 4608);
    case MAP_GATE: return 4768 + n;
    case MAP_UQ: { const int h = n / 96, c = n % 96; return (c < 64) ? (96 * h + c) : (96 * h + 64 + pair8(c - 64, 16)); }
    case MAP_UKV: { const int h = (n & 511) >> 6, d = n & 63; return 128 * h + d + ((n >= 512) ? 64 : 0); }
    case MAP_FI: { const int q = n >> 3, j = n & 7; return (j < 4) ? (4 * q + j) : (DFF + 4 * q + (j - 4)); }
    default: return n;
    }
}
__device__ __forceinline__ void transpose_item(const float* W, int K, int Nsrc, const float* ksc, bf16_t* WT, int mapid, int nblk, LAS float* scr, int item, int lane) {
    const int kb = item / nblk, nb = item % nblk, k0 = 64 * kb, n0 = 32 * nb;
    const int sc = map_col(mapid, n0 + (lane & 31));
    float tv[32];
#pragma unroll
    for (int i = 0; i < 32; ++i) { const int kk = 2 * i + (lane >> 5); tv[i] = (sc >= 0) ? W[(size_t)(k0 + kk) * Nsrc + sc] : 0.f; }
#pragma unroll
    for (int i = 0; i < 32; ++i) { const int kk = 2 * i + (lane >> 5); float v = tv[i]; if (ksc) v *= ksc[k0 + kk]; scr[kk * 33 + (lane & 31)] = v; }
    asm volatile("s_waitcnt lgkmcnt(0)" ::: "memory");
    const int c = lane & 7;
#pragma unroll
    for (int j = 0; j < 4; ++j) { const int n = (lane >> 3) + 8 * j; const LAS float* s = scr + (8 * c) * 33 + n;
        u32x4 o; o.x = cvt_pk_bf16(s[0 * 33], s[1 * 33]); o.y = cvt_pk_bf16(s[2 * 33], s[3 * 33]); o.z = cvt_pk_bf16(s[4 * 33], s[5 * 33]); o.w = cvt_pk_bf16(s[6 * 33], s[7 * 33]);
        *(u32x4*)(WT + (size_t)(n0 + n) * K + k0 + 8 * c) = o; }
    asm volatile("s_waitcnt lgkmcnt(0)" ::: "memory");
}

constexpr size_t WO_INA = 0, WO_GATE = WO_INA + (size_t)4864 * 1024, WO_UQ = WO_GATE + (size_t)4096 * 1024, WO_UKV = WO_UQ + (size_t)768 * 384, WO_BR = WO_UKV + (size_t)1024 * 256,
                 WO_OUT = WO_BR + (size_t)1024 * 2048, WO_FI = WO_OUT + (size_t)1024 * 1024, WO_FO = WO_FI + (size_t)5632 * 1024, WL_ELEMS = WO_FO + (size_t)1024 * 2816;
constexpr size_t OFF_W = 0, OFF_XB = OFF_W + 2 * WL_ELEMS * 2, OFF_SSQ = OFF_XB + (size_t)MTOT * 1024 * 2, OFF_TAB = OFF_SSQ + (size_t)MTOT * 16 * 4, OFF_PG = OFF_TAB + (size_t)MTOT * 96 * 4,
                 OFF_CQ = OFF_PG + (size_t)4 * MH * 1024 * 2, OFF_CKV = OFF_CQ + (size_t)MH * 512 * 2, OFF_SQQ = OFF_CKV + (size_t)MH * 256 * 2, OFF_SQKV = OFF_SQQ + (size_t)MH * 8 * 4,
                 OFF_Q = OFF_SQKV + (size_t)MH * 4 * 4, OFF_KV = OFF_Q + (size_t)MH * 768 * 2, OFF_Y = OFF_KV + (size_t)MH * 1024 * 2, OFF_RVT = OFF_Y + (size_t)MH * 2048 * 2, OFF_BAR = OFF_RVT + (size_t)MH * 512 * 2, OFF_RKT = OFF_BAR + 16384, OFF_KVT = OFF_RKT + (size_t)MH * 256 * 2, OFF_RQKG = OFF_KVT + (size_t)512 * 128 * 64 * 4, OFF_END = OFF_RQKG + (size_t)MH * 1024 * 2;
static_assert(OFF_XB % 256 == 0 && OFF_END <= (size_t)536870912 && OFF_PG + (size_t)MTOT * DFF * 2 <= OFF_KV, "workspace map");

struct Args { const float* in[20]; float* out; unsigned char* ws; };

constexpr int I_INA = 16 * 152, I_GATE = 16 * 128, I_UQ = 6 * 24, I_UKV = 4 * 32, I_BR = 32 * 32, I_OUT = 16 * 32, I_FI = 16 * 176, I_FO = 44 * 32;
constexpr int I_L = I_INA + I_GATE + I_UQ + I_UKV + I_BR + I_OUT + I_FI + I_FO;
__device__ __forceinline__ void convert_weight_item(const Args& a, int it, LAS float* scr, int lane) {
    bf16_t* Wb = (bf16_t*)(a.ws + OFF_W);
    const int l = it / I_L; int r = it % I_L; bf16_t* WL = Wb + (size_t)l * WL_ELEMS;
    const float* w_in = a.in[3] + (size_t)l * 1024 * NIN;
    if (r < I_INA) { transpose_item(w_in, 1024, NIN, a.in[2] + l * 1024, WL + WO_INA, MAP_INA, 152, scr, r, lane); return; } r -= I_INA;
    if (r < I_GATE) { transpose_item(w_in, 1024, NIN, a.in[2] + l * 1024, WL + WO_GATE, MAP_GATE, 128, scr, r, lane); return; } r -= I_GATE;
    if (r < I_UQ) { transpose_item(a.in[11] + (size_t)l * 384 * 768, 384, 768, a.in[10] + l * 384, WL + WO_UQ, MAP_UQ, 24, scr, r, lane); return; } r -= I_UQ;
    if (r < I_UKV) { transpose_item(a.in[13] + (size_t)l * 256 * 1024, 256, 1024, a.in[12] + l * 256, WL + WO_UKV, MAP_UKV, 32, scr, r, lane); return; } r -= I_UKV;
    if (r < I_BR) { transpose_item(a.in[14] + (size_t)l * 2048 * 1024, 2048, 1024, nullptr, WL + WO_BR, MAP_NAT, 32, scr, r, lane); return; } r -= I_BR;
    if (r < I_OUT) { transpose_item(a.in[15] + (size_t)l * 1024 * 1024, 1024, 1024, nullptr, WL + WO_OUT, MAP_NAT, 32, scr, r, lane); return; } r -= I_OUT;
    if (r < I_FI) { transpose_item(a.in[17] + (size_t)l * 1024 * 2 * DFF, 1024, 2 * DFF, a.in[16] + l * 1024, WL + WO_FI, MAP_FI, 176, scr, r, lane); return; } r -= I_FI;
    transpose_item(a.in[18] + (size_t)l * DFF * 1024, DFF, 1024, nullptr, WL + WO_FO, MAP_NAT, 32, scr, r, lane);
}
__device__ __forceinline__ bool defer_layer1_weights() { return gridDim.x == 256; }
__device__ __forceinline__ void tail_convert(const Args& a, LAS unsigned char* lds, int quarter) {
    if (!defer_layer1_weights() || blockIdx.x < 192) return;
    int tid_ = threadIdx.x; asm volatile("" : "+v"(tid_)); const int lane = tid_ & 63, wave = __builtin_amdgcn_readfirstlane(tid_ >> 6);
    LAS float* scr = (LAS float*)(lds + wave * 16384);
    const int w = ((int)blockIdx.x - 192) * 8 + wave, lo = I_L + quarter * (I_L / 4), hi = I_L + (quarter + 1) * (I_L / 4);
    for (int it = lo + w; it < hi; it += 64 * 8) convert_weight_item(a, it, scr, lane);
    __syncthreads();
}
__device__ __forceinline__ void p0_prep(const Args& a, LAS unsigned char* lds) {
    int tid_ = threadIdx.x; asm volatile("" : "+v"(tid_)); const int tid = tid_, lane = tid & 63, wave = __builtin_amdgcn_readfirstlane(tid >> 6);
    const int gw = blockIdx.x * 8 + wave, NGW = gridDim.x * 8;
    LAS float* scr = (LAS float*)(lds + wave * 16384);
    const int p0_items = defer_layer1_weights() ? I_L : 2 * I_L;
    for (int it = gw; it < p0_items; it += NGW) convert_weight_item(a, it, scr, lane);
    bf16_t* XB = (bf16_t*)(a.ws + OFF_XB); float* SSQ = (float*)(a.ws + OFF_SSQ);
    for (int m0 = gw * 4; m0 < MTOT; m0 += NGW * 4) {
        f32x4 v[4][4];
#pragma unroll
        for (int rr = 0; rr < 4; ++rr) { const f32x4* xr = (const f32x4*)(a.in[0] + (size_t)(m0 + rr) * 1024) + lane;
#pragma unroll
            for (int j = 0; j < 4; ++j) v[rr][j] = xr[64 * j]; }
#pragma unroll
        for (int rr = 0; rr < 4; ++rr) { const int m = m0 + rr; float s = 0.f;
#pragma unroll
            for (int j = 0; j < 4; ++j) s += hsq4(v[rr][j]);
            s = wave_sum(s);
            u32x2* o8 = (u32x2*)(XB + (size_t)m * 1024) + lane;
#pragma unroll
            for (int j = 0; j < 4; ++j) { u32x2 w; w.x = cvt_pk_bf16(v[rr][j][0], v[rr][j][1]); w.y = cvt_pk_bf16(v[rr][j][2], v[rr][j][3]); o8[64 * j] = w; }
            if (lane < 16) SSQ[(size_t)m * 16 + lane] = (lane == 0) ? s : 0.f; }
    }
    float* tmc = (float*)(a.ws + OFF_TAB); float* tms = tmc + (size_t)MTOT * 16; float* trc = tms + (size_t)MTOT * 16; float* trs = trc + (size_t)MTOT * 32;
    const int* pos = (const int*)a.in[1];
    for (int i = blockIdx.x * 512 + tid; i < MTOT * 48; i += gridDim.x * 512) {
        const int t = i / 48, j = i % 48; const bool mla = j < 16; const int f = mla ? j : (j - 16);
        const float inv = exp2f(-(float)(2 * f) / (mla ? 32.0f : 64.0f) * 13.287712379549449f);
        const float ang = (float)pos[t] * inv;
        const double rev = (double)ang * 0.15915494309189535; const float fr = (float)(rev - floor(rev));
        const float c = __builtin_amdgcn_cosf(fr), s = __builtin_amdgcn_sinf(fr);
        if (mla) { tmc[(size_t)t * 16 + f] = c; tms[(size_t)t * 16 + f] = s; } else { trc[(size_t)t * 32 + f] = c; trs[(size_t)t * 32 + f] = s; }
    }
}

__device__ __forceinline__ void conv_phase(const bf16_t* proj, const float* cw, bf16_t* Y) {
    int tid_ = threadIdx.x; asm volatile("" : "+v"(tid_));
    const int stride = gridDim.x * 512;
    for (int idx0 = blockIdx.x * 512 + tid_; idx0 < MH * 64; idx0 += 4 * stride) {
        u32x4 ab[4], x0[4], x1[4], x2[4]; const u32x4 z = (u32x4){0u, 0u, 0u, 0u};
#pragma unroll
        for (int u = 0; u < 4; ++u) { const int idx = idx0 + u * stride; if (idx < MH * 64) { const int row = idx >> 6, c = (idx & 63) * 8, t = row & (SEQ - 1); const bf16_t* p = proj + (size_t)row * LDP;
            ab[u] = *(const u32x4*)(p + PC_AB + c); x0[u] = *(const u32x4*)(p + PC_CX + c);
            x1[u] = t >= 1 ? *(const u32x4*)(p - LDP + PC_CX + c) : z; x2[u] = t >= 2 ? *(const u32x4*)(p - 2 * LDP + PC_CX + c) : z; } }
#pragma unroll
        for (int u = 0; u < 4; ++u) { const int idx = idx0 + u * stride; if (idx < MH * 64) { const int row = idx >> 6, c = (idx & 63) * 8;
            float a[8], e0[8], e1[8], e2[8]; unpack8(ab[u], a); unpack8(x0[u], e0); unpack8(x1[u], e1); unpack8(x2[u], e2);
            f32x4 o0, o1;
#pragma unroll
            for (int j = 0; j < 8; ++j) { const float v = a[j] * (cw[c + j] * e2[j] + cw[512 + c + j] * e1[j] + cw[1024 + c + j] * e0[j]); if (j < 4) o0[j] = v; else o1[j - 4] = v; }
            *(u32x4*)(Y + (size_t)row * 2048 + c) = pack8(o0, o1); } }
    }
}

__device__ __forceinline__ void sg_phase(LAS unsigned char* lds, const bf16_t* proj, const float* lng, const float* lnb, const float* ws, const float* bs, bf16_t* Y) {
    int tid_ = threadIdx.x; asm volatile("" : "+v"(tid_)); const int tid = tid_, lane = tid & 63, wid = __builtin_amdgcn_readfirstlane(tid >> 6);
    LAS bf16_t* V = (LAS bf16_t*)lds;
    for (int unit = blockIdx.x; unit < (MH / 128) * 4; unit += gridDim.x) {
        const int ch = unit >> 2, g = unit & 3, row0 = ch * 128;
        for (int r = 0; r < 16; ++r) {
            const int j = wid * 16 + r; float x[8]; unpack8(*(const u32x4*)(proj + (size_t)(row0 + j) * LDP + PC_SV + lane * 8), x);
            float s = 0.f;
#pragma unroll
            for (int k = 0; k < 8; ++k) s += x[k];
            const float mean = wave_sum(s) * (1.0f / 512.0f); float q = 0.f;
#pragma unroll
            for (int k = 0; k < 8; ++k) { x[k] -= mean; q += x[k] * x[k]; }
            const float rstd = __builtin_amdgcn_rsqf(wave_sum(q) * (1.0f / 512.0f) + EPS);
            if ((lane >> 4) == g) {
                f32x4 o0, o1;
#pragma unroll
                for (int k = 0; k < 8; ++k) { const float v = x[k] * rstd * lng[lane * 8 + k] + lnb[lane * 8 + k]; if (k < 4) o0[k] = v; else o1[k - 4] = v; }
                *(LAS u32x4*)(V + j * 128 + (lane & 15) * 8) = pack8(o0, o1);
            }
        }
        __syncthreads();
        const int d = tid & 127, iq = tid >> 7;
        for (int ii = 0; ii < 32; ++ii) {
            const int i = iq + 4 * ii; const float* wrow = ws + (size_t)(g * 128 + i) * 128; float s = 0.f;
            for (int j = 0; j <= i; ++j) s += wrow[j] * bf2f(V[j * 128 + d]);
            s += bs[g * 128 + i];
            const float uu = bf2f(proj[(size_t)(row0 + i) * LDP + PC_SU + g * 128 + d]);
            Y[(size_t)(row0 + i) * 2048 + 1024 + g * 128 + d] = (bf16_t)f2bf(uu * s);
        }
        __syncthreads();
    }
}

__device__ __forceinline__ void ret_naive(LAS unsigned char* lds, const bf16_t* proj, bf16_t* Y) {
    int tid_ = threadIdx.x; asm volatile("" : "+v"(tid_)); const int tid = tid_, lane = tid & 63, wid = __builtin_amdgcn_readfirstlane(tid >> 6), tsub = wid >> 1, eh = wid & 1;
    LAS float* X = (LAS float*)lds;
    for (int item = blockIdx.x; item < 8 * 4 * 8; item += gridDim.x) {
        const int b = item >> 5, h = (item >> 3) & 3, tb = item & 7;
        const int t = tb * 256 + tsub * 64 + lane; const size_t row = (size_t)b * SEQ + t;
        const float lg2 = __log2f(1.0f - exp2f(-(float)(5 + h)));
        float q[64], acc[64];
#pragma unroll
        for (int i = 0; i < 8; ++i) { float e[8]; unpack8(*(const u32x4*)(proj + row * LDP + PC_RQ + h * 64 + i * 8), e);
#pragma unroll
            for (int k = 0; k < 8; ++k) q[i * 8 + k] = e[k]; }
#pragma unroll
        for (int e = 0; e < 64; ++e) acc[e] = 0.f;
        const int smax = tb * 256 + tsub * 64 + 63;
        for (int s = 0; s <= smax; ++s) {
            const bf16_t* kp = proj + ((size_t)b * SEQ + s) * LDP + PC_RK + h * 64; float dot = 0.f;
#pragma unroll
            for (int i = 0; i < 8; ++i) { float e[8]; unpack8(*(const u32x4*)(kp + i * 8), e);
#pragma unroll
                for (int k = 0; k < 8; ++k) dot += q[i * 8 + k] * e[k]; }
            const int n = t - s; const float w = (n >= 0) ? exp2f((float)n * lg2) * dot : 0.f;
            const bf16_t* vp = proj + ((size_t)b * SEQ + s) * LDP + PC_RV + h * 128 + eh * 64;
#pragma unroll
            for (int i = 0; i < 8; ++i) { float e[8]; unpack8(*(const u32x4*)(vp + i * 8), e);
#pragma unroll
                for (int k = 0; k < 8; ++k) acc[i * 8 + k] += w * e[k]; }
        }
        float s1 = 0.f;
#pragma unroll
        for (int e = 0; e < 64; ++e) s1 += acc[e];
        X[(tsub * 64 + lane) * 2 + eh] = s1; __syncthreads();
        const float mean = (X[(tsub * 64 + lane) * 2] + X[(tsub * 64 + lane) * 2 + 1]) * (1.0f / 128.0f); __syncthreads();
        float s2 = 0.f;
#pragma unroll
        for (int e = 0; e < 64; ++e) { acc[e] -= mean; s2 += acc[e] * acc[e]; }
        X[(tsub * 64 + lane) * 2 + eh] = s2; __syncthreads();
        const float rstd = __builtin_amdgcn_rsqf((X[(tsub * 64 + lane) * 2] + X[(tsub * 64 + lane) * 2 + 1]) * (1.0f / 128.0f) + EPS); __syncthreads();
        const bf16_t* gp = proj + row * LDP + PC_RG + h * 128 + eh * 64; bf16_t* yp = Y + row * 2048 + 512 + h * 128 + eh * 64;
#pragma unroll
        for (int i = 0; i < 8; ++i) { float g[8]; unpack8(*(const u32x4*)(gp + i * 8), g); f32x4 o0, o1;
#pragma unroll
            for (int k = 0; k < 4; ++k) { o0[k] = acc[i * 8 + k] * rstd * g[k]; o1[k] = acc[i * 8 + 4 + k] * rstd * g[4 + k]; }
            *(u32x4*)(yp + i * 8) = pack8(o0, o1); }
    }
}

__device__ __forceinline__ void attn_naive(const bf16_t* Q, const bf16_t* KV, const bf16_t* CQ, bf16_t* Y) {
    int tid_ = threadIdx.x; asm volatile("" : "+v"(tid_)); const int tid = tid_, lane = tid & 63, wid = __builtin_amdgcn_readfirstlane(tid >> 6), tsub = wid >> 1, eh = wid & 1;
    for (int item = blockIdx.x; item < 8 * 8 * 8; item += gridDim.x) {
        const int b = item >> 6, h = (item >> 3) & 7, tb = item & 7;
        const int t = tb * 256 + tsub * 64 + lane; const size_t row = (size_t)b * SEQ + t;
        float q[96], acc[32];
#pragma unroll
        for (int i = 0; i < 12; ++i) { float e[8]; unpack8(*(const u32x4*)(Q + row * 768 + h * 96 + i * 8), e);
#pragma unroll
            for (int k = 0; k < 8; ++k) q[i * 8 + k] = e[k]; }
#pragma unroll
        for (int e = 0; e < 32; ++e) acc[e] = 0.f;
        float mx = -1e30f, l = 0.f;
        const int smax = tb * 256 + tsub * 64 + 63;
        for (int s = 0; s <= smax; ++s) {
            const size_t kr = (size_t)b * SEQ + s;
            const bf16_t* kn = KV + kr * 1024 + h * 64; const bf16_t* kp = CQ + kr * 512 + 384; float sc = 0.f;
#pragma unroll
            for (int i = 0; i < 8; ++i) { float e[8]; unpack8(*(const u32x4*)(kn + i * 8), e);
#pragma unroll
                for (int k = 0; k < 8; ++k) sc += q[i * 8 + k] * e[k]; }
#pragma unroll
            for (int i = 0; i < 4; ++i) { float e[8]; unpack8(*(const u32x4*)(kp + i * 8), e);
#pragma unroll
                for (int k = 0; k < 8; ++k) sc += q[64 + i * 8 + k] * e[k]; }
            const bool ok = s <= t;
            const float mn = ok ? fmaxf(mx, sc) : mx, corr = exp2f(mx - mn), p = ok ? exp2f(sc - mn) : 0.f;
            l = l * corr + p; mx = mn;
            const bf16_t* vp = KV + kr * 1024 + 512 + h * 64 + eh * 32;
#pragma unroll
            for (int i = 0; i < 4; ++i) { float e[8]; unpack8(*(const u32x4*)(vp + i * 8), e);
#pragma unroll
                for (int k = 0; k < 8; ++k) acc[i * 8 + k] = acc[i * 8 + k] * corr + p * e[k]; }
        }
        const float il = 1.0f / l; bf16_t* yp = Y + row * 2048 + 1536 + h * 64 + eh * 32;
#pragma unroll
        for (int i = 0; i < 4; ++i) { f32x4 o0, o1;
#pragma unroll
            for (int k = 0; k < 4; ++k) { o0[k] = acc[i * 8 + k] * il; o1[k] = acc[i * 8 + 4 + k] * il; }
            *(u32x4*)(yp + i * 8) = pack8(o0, o1); }
    }
}


typedef float f32x16 __attribute__((ext_vector_type(16)));
template <int MODE> __device__ __forceinline__ void flash_item(LAS unsigned char* lds, int b, int hd, int qb, const bf16_t* Qp, const bf16_t* Kp, const bf16_t* Kpe, const bf16_t* VT, const bf16_t* Gp, bf16_t* Y) {
    constexpr int NKS = MODE == 0 ? 6 : 4, NES = MODE == 0 ? 2 : 4, KP = MODE == 0 ? 208 : 144, VP = 144;
    constexpr int KBYTES = 64 * KP, STAGE = KBYTES + NES * 32 * VP;
    int tid_ = threadIdx.x; asm volatile("" : "+v"(tid_));
    const int tid = tid_, lane = tid & 63, wid = __builtin_amdgcn_readfirstlane(tid >> 6), r = lane & 31, hh = lane >> 5;
    const int Q0 = qb * 256 + wid * 32, query = Q0 + r; const size_t qrow = (size_t)b * SEQ + query;
    bf16x8 qf[NKS];
#pragma unroll
    for (int ks = 0; ks < NKS; ++ks) qf[ks] = (MODE == 0) ? *(const bf16x8*)(Qp + qrow * 768 + hd * 96 + ks * 16 + hh * 8) : *(const bf16x8*)(Qp + qrow * LDP + PC_RQ + hd * 64 + ks * 16 + hh * 8);
    f32x16 o[NES];
#pragma unroll
    for (int e = 0; e < NES; ++e)
#pragma unroll
        for (int i = 0; i < 16; ++i) o[e][i] = 0.f;
    float mrun = -1e30f, lrun = 0.f;
    const float lg2 = (MODE == 1) ? __log2f(1.0f - exp2f(-(float)(5 + hd))) : 0.f;
    float cdec[16];
    if (MODE == 1) {
#pragma unroll
        for (int i = 0; i < 16; ++i) cdec[i] = exp2f(-(float)((i & 3) + 8 * (i >> 2) + 4 * hh) * lg2);
    }
    const int nt = 4 * qb + 4, my_last = Q0 >> 6;
    const bf16_t *g0, *g1, *g2; unsigned l0, l1, l2; size_t st0, st1, st2;
    if (MODE == 0) {
        g0 = Kp + ((size_t)b * SEQ + (tid >> 3)) * 512 + hd * 64 + (tid & 7) * 8; st0 = (size_t)64 * 512; l0 = (tid >> 3) * KP + (tid & 7) * 16;
        g1 = Kpe + ((size_t)b * SEQ + ((tid & 255) >> 2)) * 512 + 384 + (tid & 3) * 8; st1 = (size_t)64 * 512; l1 = ((tid & 255) >> 2) * KP + 128 + (tid & 3) * 16;
        g2 = VT + ((size_t)(b * 8 + hd) * 64 + (tid >> 3)) * SEQ + (tid & 7) * 8; st2 = 64; l2 = KBYTES + (tid >> 3) * VP + (tid & 7) * 16;
    } else {
        g0 = Kp + ((size_t)b * SEQ + (tid >> 3)) * LDP + PC_RK + hd * 64 + (tid & 7) * 8; st0 = (size_t)64 * LDP; l0 = (tid >> 3) * KP + (tid & 7) * 16;
        g1 = VT + ((size_t)(b * 4 + hd) * 128 + (tid >> 3)) * SEQ + (tid & 7) * 8; st1 = 64; l1 = KBYTES + (tid >> 3) * VP + (tid & 7) * 16;
        g2 = g1 + (size_t)64 * SEQ; st2 = 64; l2 = l1 + 64 * VP;
    }
    const bool has1 = (MODE == 1) || (tid < 256);
    u32x4 a0, a1 = (u32x4){0u, 0u, 0u, 0u}, a2, b0, b1 = (u32x4){0u, 0u, 0u, 0u}, b2;
#define FL_LOAD(x0, x1, x2, tt) do { x0 = *(const u32x4*)(g0 + (size_t)(tt) * st0); if (has1) x1 = *(const u32x4*)(g1 + (size_t)(tt) * st1); x2 = *(const u32x4*)(g2 + (size_t)(tt) * st2); } while (0)
#define FL_STORE(x0, x1, x2, tt) do { LAS unsigned char* nb_ = lds + ((tt) & 1) * STAGE; *(LAS u32x4*)(nb_ + l0) = x0; if (has1) *(LAS u32x4*)(nb_ + l1) = x1; *(LAS u32x4*)(nb_ + l2) = x2; } while (0)
    FL_LOAD(a0, a1, a2, 0); FL_STORE(a0, a1, a2, 0);
    b0 = a0; b2 = a2; if (nt > 1) FL_LOAD(b0, b1, b2, 1);
    __syncthreads();
    auto compute = [&](const int t) __attribute__((always_inline)) {
        LAS unsigned char* buf = lds + (t & 1) * STAGE;
        if (t <= my_last) {
            f32x16 s[2];
            {
                bf16x8 kf[2][NKS];
#pragma unroll
                for (int sub = 0; sub < 2; ++sub)
#pragma unroll
                    for (int ks = 0; ks < NKS; ++ks) kf[sub][ks] = *(const LAS bf16x8*)(buf + (32 * sub + r) * KP + ks * 32 + hh * 16);
#pragma unroll
                for (int sub = 0; sub < 2; ++sub)
#pragma unroll
                    for (int i = 0; i < 16; ++i) s[sub][i] = 0.f;
                __builtin_amdgcn_sched_barrier(0);
#pragma unroll
                for (int ks = 0; ks < NKS; ++ks)
#pragma unroll
                    for (int sub = 0; sub < 2; ++sub) s[sub] = __builtin_amdgcn_mfma_f32_32x32x16_bf16(kf[sub][ks], qf[ks], s[sub], 0, 0, 0);
            }
            const int kbase = 64 * t + 4 * hh;
            if (MODE == 0) {
                if (t == my_last) {
#pragma unroll
                    for (int sub = 0; sub < 2; ++sub)
#pragma unroll
                        for (int i = 0; i < 16; ++i) if (kbase + 32 * sub + (i & 3) + 8 * (i >> 2) > query) s[sub][i] = -1e30f;
                }
                float mx0 = fmaxf(fmaxf(s[0][0], s[0][1]), s[0][2]), mx1 = fmaxf(fmaxf(s[1][0], s[1][1]), s[1][2]);
#pragma unroll
                for (int i = 3; i < 15; i += 2) { mx0 = fmaxf(fmaxf(mx0, s[0][i]), s[0][i + 1]); mx1 = fmaxf(fmaxf(mx1, s[1][i]), s[1][i + 1]); }
                float mx = fmaxf(fmaxf(mx0, mx1), fmaxf(s[0][15], s[1][15]));
                mx = fmaxf(mx, __shfl_xor(mx, 32));
                if (__builtin_amdgcn_ballot_w64(mx > mrun + 6.0f) != 0ull) {
                    const float mn = fmaxf(mrun, mx), corr = fast_exp2(mrun - mn); mrun = mn; lrun *= corr;
#pragma unroll
                    for (int e = 0; e < NES; ++e)
#pragma unroll
                        for (int i = 0; i < 16; ++i) o[e][i] *= corr;
                }
                float ls0 = 0.f, ls1 = 0.f;
#pragma unroll
                for (int i = 0; i < 16; ++i) { s[0][i] = fast_exp2(s[0][i] - mrun); ls0 += s[0][i]; s[1][i] = fast_exp2(s[1][i] - mrun); ls1 += s[1][i]; }
                lrun += ls0 + ls1;
            } else {
#pragma unroll
                for (int sub = 0; sub < 2; ++sub) {
                    const float f = fast_exp2((float)(query - 64 * t - 32 * sub) * lg2);
#pragma unroll
                    for (int i = 0; i < 16; ++i) s[sub][i] *= f * cdec[i];
                }
                if (t == my_last) {
#pragma unroll
                    for (int sub = 0; sub < 2; ++sub)
#pragma unroll
                        for (int i = 0; i < 16; ++i) if (kbase + 32 * sub + (i & 3) + 8 * (i >> 2) > query) s[sub][i] = 0.f;
                }
            }
            bf16x8 pf[2][2];
#pragma unroll
            for (int sub = 0; sub < 2; ++sub)
#pragma unroll
                for (int s2 = 0; s2 < 2; ++s2) { u32x4 w; w.x = cvt_pk_bf16(s[sub][8 * s2 + 0], s[sub][8 * s2 + 1]); w.y = cvt_pk_bf16(s[sub][8 * s2 + 2], s[sub][8 * s2 + 3]);
                    w.z = cvt_pk_bf16(s[sub][8 * s2 + 4], s[sub][8 * s2 + 5]); w.w = cvt_pk_bf16(s[sub][8 * s2 + 6], s[sub][8 * s2 + 7]); pf[sub][s2] = __builtin_bit_cast(bf16x8, w); }
#pragma unroll
            for (int ep = 0; ep < NES; ep += 2) {
                bf16x8 vf[2][4];
#pragma unroll
                for (int e = 0; e < 2; ++e)
#pragma unroll
                    for (int kk = 0; kk < 4; ++kk) vf[e][kk] = *(const LAS bf16x8*)(buf + KBYTES + (32 * (ep + e) + r) * VP + kk * 32 + hh * 16);
                __builtin_amdgcn_sched_barrier(0);
#pragma unroll
                for (int kk = 0; kk < 4; ++kk)
#pragma unroll
                    for (int e = 0; e < 2; ++e) o[ep + e] = __builtin_amdgcn_mfma_f32_32x32x16_bf16(vf[e][kk], pf[kk >> 1][kk & 1], o[ep + e], 0, 0, 0);
            }
        }
    };
    for (int t = 0; t < nt; t += 2) {
        if (t + 2 < nt) FL_LOAD(a0, a1, a2, t + 2);
        compute(t);
        if (t + 1 < nt) FL_STORE(b0, b1, b2, t + 1);
        __syncthreads();
        if (t + 1 >= nt) break;
        if (t + 3 < nt) FL_LOAD(b0, b1, b2, t + 3);
        compute(t + 1);
        if (t + 2 < nt) FL_STORE(a0, a1, a2, t + 2);
        __syncthreads();
    }
#undef FL_LOAD
#undef FL_STORE
    if (MODE == 0) {
        const float inv = 1.0f / (lrun + __shfl_xor(lrun, 32));
        bf16_t* yp = Y + qrow * 2048 + 1536 + hd * 64 + 4 * hh;
#pragma unroll
        for (int e = 0; e < NES; ++e)
#pragma unroll
            for (int g = 0; g < 4; ++g) { u32x2 w; w.x = cvt_pk_bf16(o[e][4 * g] * inv, o[e][4 * g + 1] * inv); w.y = cvt_pk_bf16(o[e][4 * g + 2] * inv, o[e][4 * g + 3] * inv); *(u32x2*)(yp + 32 * e + 8 * g) = w; }
    } else {
        float s1 = 0.f;
#pragma unroll
        for (int e = 0; e < NES; ++e)
#pragma unroll
            for (int i = 0; i < 16; ++i) s1 += o[e][i];
        const float mean = (s1 + __shfl_xor(s1, 32)) * (1.0f / 128.0f); float s2 = 0.f;
#pragma unroll
        for (int e = 0; e < NES; ++e)
#pragma unroll
            for (int i = 0; i < 16; ++i) { o[e][i] -= mean; s2 += o[e][i] * o[e][i]; }
        const float rstd = __builtin_amdgcn_rsqf((s2 + __shfl_xor(s2, 32)) * (1.0f / 128.0f) + EPS);
        const bf16_t* gp = Gp + qrow * LDP + PC_RG + hd * 128 + 4 * hh; bf16_t* yp = Y + qrow * 2048 + 512 + hd * 128 + 4 * hh;
#pragma unroll
        for (int e = 0; e < NES; ++e)
#pragma unroll
            for (int g = 0; g < 4; ++g) { const u32x2 gw = *(const u32x2*)(gp + 32 * e + 8 * g);
                u32x2 w; w.x = cvt_pk_bf16(o[e][4 * g] * rstd * bflo(gw.x), o[e][4 * g + 1] * rstd * bfhi(gw.x)); w.y = cvt_pk_bf16(o[e][4 * g + 2] * rstd * bflo(gw.y), o[e][4 * g + 3] * rstd * bfhi(gw.y)); *(u32x2*)(yp + 32 * e + 8 * g) = w; }
    }
}
__device__ __forceinline__ void attn_phase(LAS unsigned char* lds, const bf16_t* Q, const bf16_t* KN, const bf16_t* CQ, const bf16_t* VT, bf16_t* Y) {
    const int vid0 = (gridDim.x % 8 == 0) ? (int)((blockIdx.x % 8) * (gridDim.x / 8) + blockIdx.x / 8) : (int)blockIdx.x;
    for (int pr = vid0; pr < 256; pr += gridDim.x) {
        const int bh = pr >> 2, p = pr & 3;
        flash_item<0>(lds, bh >> 3, bh & 7, 7 - p, Q, KN, CQ, VT, nullptr, Y);
        flash_item<0>(lds, bh >> 3, bh & 7, p, Q, KN, CQ, VT, nullptr, Y);
    }
}
__device__ __forceinline__ void ret_phase(LAS unsigned char* lds, const bf16_t* proj, const bf16_t* RVT, bf16_t* Y) {
    for (int it = blockIdx.x; it < 256; it += gridDim.x) { const int bh = it >> 3, qb = it & 7; flash_item<1>(lds, bh >> 2, bh & 3, qb, proj, proj, nullptr, RVT, proj, Y); }
}


__device__ __forceinline__ void sg_phase2(LAS unsigned char* lds, const bf16_t* proj, const float* lng, const float* lnb, const float* ws, const float* bs, bf16_t* Y) {
    int tid_ = threadIdx.x; asm volatile("" : "+v"(tid_));
    const int tid = tid_, lane = tid & 63, wid = __builtin_amdgcn_readfirstlane(tid >> 6), r = lane & 31, hh = lane >> 5;
    constexpr int PB = 272;
    LAS unsigned char* Wl = lds; LAS unsigned char* Vl = lds + 128 * PB; LAS float* St = (LAS float*)(lds + 2 * 128 * PB);
    int gcur = -1;
    for (int unit = blockIdx.x; unit < (MH / 128) * 4; unit += gridDim.x) {
        const int g = unit & 3, ch = unit >> 2, row0 = ch * 128;
        {
            const int rrow = wid * 16 + (lane >> 2), qq = lane & 3;
            const bf16_t* rp = proj + (size_t)(row0 + rrow) * LDP + PC_SV + qq * 8;
            u32x4 xr[16];
#pragma unroll
            for (int i = 0; i < 16; ++i) xr[i] = *(const u32x4*)(rp + i * 32);
            if (g != gcur) {
                gcur = g; const int i = tid >> 2, q = tid & 3; const float* wp = ws + (size_t)(g * 128 + i) * 128 + 32 * q;
#pragma unroll
                for (int c = 0; c < 4; ++c) { f32x4 a = *(const f32x4*)(wp + 8 * c), bq = *(const f32x4*)(wp + 8 * c + 4);
#pragma unroll
                    for (int k = 0; k < 4; ++k) { if (32 * q + 8 * c + k > i) a[k] = 0.f; if (32 * q + 8 * c + 4 + k > i) bq[k] = 0.f; }
                    *(LAS u32x4*)(Wl + i * PB + (32 * q + 8 * c) * 2) = pack8(a, bq); }
            }
            float sm = 0.f;
#pragma unroll
            for (int i = 0; i < 16; ++i) { float x[8]; unpack8(xr[i], x);
#pragma unroll
                for (int k = 0; k < 8; ++k) sm += x[k]; }
            sm += __shfl_xor(sm, 1); sm += __shfl_xor(sm, 2);
            const float mean = sm * (1.0f / 512.0f); float q2 = 0.f;
#pragma unroll
            for (int i = 0; i < 16; ++i) { float x[8]; unpack8(xr[i], x);
#pragma unroll
                for (int k = 0; k < 8; ++k) { const float d = x[k] - mean; q2 += d * d; } }
            q2 += __shfl_xor(q2, 1); q2 += __shfl_xor(q2, 2);
            if (qq == 0) { St[2 * rrow] = mean; St[2 * rrow + 1] = __builtin_amdgcn_rsqf(q2 * (1.0f / 512.0f) + EPS); }
        }
        __syncthreads();
        {
            const int d = tid & 127, jb = tid >> 7; const float gg = lng[g * 128 + d], bb = lnb[g * 128 + d];
            const bf16_t* xp = proj + (size_t)(row0 + 32 * jb) * LDP + PC_SV + g * 128 + d;
#pragma unroll
            for (int c = 0; c < 4; ++c) { f32x4 a, bq;
#pragma unroll
                for (int k = 0; k < 4; ++k) { const int j0 = 8 * c + k, j1 = 8 * c + 4 + k;
                    a[k] = (bf2f(xp[(size_t)j0 * LDP]) - St[2 * (32 * jb + j0)]) * St[2 * (32 * jb + j0) + 1] * gg + bb;
                    bq[k] = (bf2f(xp[(size_t)j1 * LDP]) - St[2 * (32 * jb + j1)]) * St[2 * (32 * jb + j1) + 1] * gg + bb; }
                *(LAS u32x4*)(Vl + d * PB + (32 * jb + 8 * c) * 2) = pack8(a, bq); }
        }
        __syncthreads();
        {
            const int ib = wid >> 1, db0 = 2 * (wid & 1);
            f32x16 acc[2];
#pragma unroll
            for (int e = 0; e < 2; ++e)
#pragma unroll
                for (int i = 0; i < 16; ++i) acc[e][i] = 0.f;
            unsigned short uraw[2][16]; float bsv[16];
#pragma unroll
            for (int i = 0; i < 16; ++i) { const int ii = 32 * ib + (i & 3) + 8 * (i >> 2) + 4 * hh; bsv[i] = bs[g * 128 + ii];
#pragma unroll
                for (int e = 0; e < 2; ++e) uraw[e][i] = proj[(size_t)(row0 + ii) * LDP + PC_SU + g * 128 + 32 * (db0 + e) + r]; }
            for (int ks = 0; ks < 2 * ib + 2; ++ks) {
                const bf16x8 af = *(const LAS bf16x8*)(Wl + (32 * ib + r) * PB + ks * 32 + hh * 16);
#pragma unroll
                for (int e = 0; e < 2; ++e) { const bf16x8 bf = *(const LAS bf16x8*)(Vl + (32 * (db0 + e) + r) * PB + ks * 32 + hh * 16); acc[e] = __builtin_amdgcn_mfma_f32_32x32x16_bf16(af, bf, acc[e], 0, 0, 0); }
            }
#pragma unroll
            for (int e = 0; e < 2; ++e)
#pragma unroll
                for (int i = 0; i < 16; ++i) { const int ii = 32 * ib + (i & 3) + 8 * (i >> 2) + 4 * hh, dd = g * 128 + 32 * (db0 + e) + r;
                    Y[(size_t)(row0 + ii) * 2048 + 1024 + dd] = (bf16_t)f2bf(bf2f(uraw[e][i]) * (acc[e][i] + bsv[i])); }
        }
        __syncthreads();
    }
}


__device__ __forceinline__ void ret_item2(LAS unsigned char* lds, int b, int hd, int qb16, const bf16_t* proj, const bf16_t* VT, bf16_t* Y) {
    constexpr int NKS = 4, NES = 4, KP = 144, VP = 272;
    constexpr int KBYTES = 128 * KP, STAGE = KBYTES + 128 * VP;
    int tid_ = threadIdx.x; asm volatile("" : "+v"(tid_));
    const int tid = tid_, lane = tid & 63, wid = __builtin_amdgcn_readfirstlane(tid >> 6), r = lane & 31, hh = lane >> 5, kh = wid >> 2;
    const int Q0 = qb16 * 128 + (wid & 3) * 32, query = Q0 + r; const size_t qrow = (size_t)b * SEQ + query;
    bf16x8 qf[NKS];
#pragma unroll
    for (int ks = 0; ks < NKS; ++ks) qf[ks] = *(const bf16x8*)(proj + qrow * LDP + PC_RQ + hd * 64 + ks * 16 + hh * 8);
    f32x16 o[NES];
#pragma unroll
    for (int e = 0; e < NES; ++e)
#pragma unroll
        for (int i = 0; i < 16; ++i) o[e][i] = 0.f;
    const float lg2 = __log2f(1.0f - exp2f(-(float)(5 + hd)));
    float cdec[16];
#pragma unroll
    for (int i = 0; i < 16; ++i) cdec[i] = exp2f(-(float)((i & 3) + 8 * (i >> 2) + 4 * hh) * lg2);
    const int nt = qb16 + 1, my_last = Q0 >> 6;
    const bf16_t* gk = proj + ((size_t)b * SEQ + (tid >> 3)) * LDP + PC_RK + hd * 64 + (tid & 7) * 8;
    const bf16_t* gv = VT + ((size_t)(b * 4 + hd) * 128 + (tid >> 4)) * SEQ + (tid & 15) * 8;
    const unsigned lk = (tid >> 3) * KP + (tid & 7) * 16, lv = KBYTES + (tid >> 4) * VP + (tid & 15) * 16;
    u32x4 ak[2], av[4], bk[2], bv[4];
#define RT_LOAD(xk, xv, tt) do { _Pragma("unroll") for (int i_ = 0; i_ < 2; ++i_) xk[i_] = *(const u32x4*)(gk + (size_t)(128 * (tt) + 64 * i_) * LDP); \
        _Pragma("unroll") for (int i_ = 0; i_ < 4; ++i_) xv[i_] = *(const u32x4*)(gv + (size_t)(32 * i_) * SEQ + 128 * (tt)); } while (0)
#define RT_STORE(xk, xv, tt) do { LAS unsigned char* nb_ = lds + ((tt) & 1) * STAGE; _Pragma("unroll") for (int i_ = 0; i_ < 2; ++i_) *(LAS u32x4*)(nb_ + lk + 64 * i_ * KP) = xk[i_]; \
        _Pragma("unroll") for (int i_ = 0; i_ < 4; ++i_) *(LAS u32x4*)(nb_ + lv + 32 * i_ * VP) = xv[i_]; } while (0)
    RT_LOAD(ak, av, 0); RT_STORE(ak, av, 0);
#pragma unroll
    for (int i = 0; i < 2; ++i) bk[i] = ak[i];
#pragma unroll
    for (int i = 0; i < 4; ++i) bv[i] = av[i];
    if (nt > 1) RT_LOAD(bk, bv, 1);
    __syncthreads();
    auto compute = [&](const int t) __attribute__((always_inline)) {
        LAS unsigned char* buf = lds + (t & 1) * STAGE;
        const int tile = 2 * t + kh;
        if (tile <= my_last) {
            f32x16 s[2];
            {
                bf16x8 kf[2][NKS];
#pragma unroll
                for (int sub = 0; sub < 2; ++sub)
#pragma unroll
                    for (int ks = 0; ks < NKS; ++ks) kf[sub][ks] = *(const LAS bf16x8*)(buf + (64 * kh + 32 * sub + r) * KP + ks * 32 + hh * 16);
#pragma unroll
                for (int sub = 0; sub < 2; ++sub)
#pragma unroll
                    for (int i = 0; i < 16; ++i) s[sub][i] = 0.f;
                __builtin_amdgcn_sched_barrier(0);
#pragma unroll
                for (int ks = 0; ks < NKS; ++ks)
#pragma unroll
                    for (int sub = 0; sub < 2; ++sub) s[sub] = __builtin_amdgcn_mfma_f32_32x32x16_bf16(kf[sub][ks], qf[ks], s[sub], 0, 0, 0);
            }
            const int kbase = 64 * tile + 4 * hh;
#pragma unroll
            for (int sub = 0; sub < 2; ++sub) {
                const float f = fast_exp2((float)(query - 64 * tile - 32 * sub) * lg2);
#pragma unroll
                for (int i = 0; i < 16; ++i) s[sub][i] *= f * cdec[i];
            }
            if (tile == my_last) {
#pragma unroll
                for (int sub = 0; sub < 2; ++sub)
#pragma unroll
                    for (int i = 0; i < 16; ++i) if (kbase + 32 * sub + (i & 3) + 8 * (i >> 2) > query) s[sub][i] = 0.f;
            }
            bf16x8 pf[2][2];
#pragma unroll
            for (int sub = 0; sub < 2; ++sub)
#pragma unroll
                for (int s2 = 0; s2 < 2; ++s2) { u32x4 w; w.x = cvt_pk_bf16(s[sub][8 * s2 + 0], s[sub][8 * s2 + 1]); w.y = cvt_pk_bf16(s[sub][8 * s2 + 2], s[sub][8 * s2 + 3]);
                    w.z = cvt_pk_bf16(s[sub][8 * s2 + 4], s[sub][8 * s2 + 5]); w.w = cvt_pk_bf16(s[sub][8 * s2 + 6], s[sub][8 * s2 + 7]); pf[sub][s2] = __builtin_bit_cast(bf16x8, w); }
#pragma unroll
            for (int ep = 0; ep < NES; ep += 2) {
                bf16x8 vf[2][4];
#pragma unroll
                for (int e = 0; e < 2; ++e)
#pragma unroll
                    for (int kk = 0; kk < 4; ++kk) vf[e][kk] = *(const LAS bf16x8*)(buf + KBYTES + (32 * (ep + e) + r) * VP + (4 * kh + kk) * 32 + hh * 16);
                __builtin_amdgcn_sched_barrier(0);
#pragma unroll
                for (int kk = 0; kk < 4; ++kk)
#pragma unroll
                    for (int e = 0; e < 2; ++e) o[ep + e] = __builtin_amdgcn_mfma_f32_32x32x16_bf16(vf[e][kk], pf[kk >> 1][kk & 1], o[ep + e], 0, 0, 0);
            }
        }
    };
    for (int t = 0; t < nt; t += 2) {
        if (t + 2 < nt) RT_LOAD(ak, av, t + 2);
        compute(t);
        if (t + 1 < nt) RT_STORE(bk, bv, t + 1);
        __syncthreads();
        if (t + 1 >= nt) break;
        if (t + 3 < nt) RT_LOAD(bk, bv, t + 3);
        compute(t + 1);
        if (t + 2 < nt) RT_STORE(ak, av, t + 2);
        __syncthreads();
    }
#undef RT_LOAD
#undef RT_STORE
    LAS float* X = (LAS float*)lds;
    if (kh == 1) {
#pragma unroll
        for (int e = 0; e < NES; ++e)
#pragma unroll
            for (int i = 0; i < 16; ++i) X[((wid & 3) * 64 + e * 16 + i) * 64 + lane] = o[e][i];
    }
    __syncthreads();
    if (kh == 0) {
#pragma unroll
        for (int e = 0; e < NES; ++e)
#pragma unroll
            for (int i = 0; i < 16; ++i) o[e][i] += X[((wid & 3) * 64 + e * 16 + i) * 64 + lane];
        float s1 = 0.f;
#pragma unroll
        for (int e = 0; e < NES; ++e)
#pragma unroll
            for (int i = 0; i < 16; ++i) s1 += o[e][i];
        const float mean = (s1 + __shfl_xor(s1, 32)) * (1.0f / 128.0f); float s2 = 0.f;
#pragma unroll
        for (int e = 0; e < NES; ++e)
#pragma unroll
            for (int i = 0; i < 16; ++i) { o[e][i] -= mean; s2 += o[e][i] * o[e][i]; }
        const float rstd = __builtin_amdgcn_rsqf((s2 + __shfl_xor(s2, 32)) * (1.0f / 128.0f) + EPS);
        const bf16_t* gp = proj + qrow * LDP + PC_RG + hd * 128 + 4 * hh; bf16_t* yp = Y + qrow * 2048 + 512 + hd * 128 + 4 * hh;
#pragma unroll
        for (int e = 0; e < NES; ++e)
#pragma unroll
            for (int g = 0; g < 4; ++g) { const u32x2 gw = *(const u32x2*)(gp + 32 * e + 8 * g);
                u32x2 w; w.x = cvt_pk_bf16(o[e][4 * g] * rstd * bflo(gw.x), o[e][4 * g + 1] * rstd * bfhi(gw.x)); w.y = cvt_pk_bf16(o[e][4 * g + 2] * rstd * bflo(gw.y), o[e][4 * g + 3] * rstd * bfhi(gw.y)); *(u32x2*)(yp + 32 * e + 8 * g) = w; }
    }
    __syncthreads();
}
__device__ __forceinline__ void ret_phase2(LAS unsigned char* lds, const bf16_t* proj, const bf16_t* RVT, bf16_t* Y) {
    const int vid0 = (gridDim.x % 8 == 0) ? (int)((blockIdx.x % 8) * (gridDim.x / 8) + blockIdx.x / 8) : (int)blockIdx.x;
    for (int pr = vid0; pr < 256; pr += gridDim.x) { const int bh = pr >> 3, p = pr & 7;
        ret_item2(lds, bh >> 2, bh & 3, 15 - p, proj, RVT, Y);
        ret_item2(lds, bh >> 2, bh & 3, p, proj, RVT, Y); }
}


__device__ __forceinline__ void kvt_phase(const bf16_t* RVT, const bf16_t* RKT, float* KVT) {
    int tid_ = threadIdx.x; asm volatile("" : "+v"(tid_));
    const int tid = tid_, lane = tid & 63, wid = __builtin_amdgcn_readfirstlane(tid >> 6), r = lane & 31, hh = lane >> 5, es = wid >> 1, ds = wid & 1;
    for (int unit0 = blockIdx.x; unit0 < 512; unit0 += 2 * gridDim.x) {
        const int unit1 = unit0 + gridDim.x; const bool two = unit1 < 512; const int u1 = two ? unit1 : unit0;
        bf16x8 vf[2][8], kf[2][8];
#pragma unroll
        for (int q = 0; q < 2; ++q) { const int unit = q ? u1 : unit0, bh = unit >> 4, m = unit & 15;
            const bf16_t* vp = RVT + ((size_t)bh * 128 + 32 * es + r) * SEQ + 128 * m + 8 * hh;
            const bf16_t* kp = RKT + ((size_t)bh * 64 + 32 * ds + r) * SEQ + 128 * m + 8 * hh;
#pragma unroll
            for (int kk = 0; kk < 8; ++kk) { vf[q][kk] = *(const bf16x8*)(vp + 16 * kk); kf[q][kk] = *(const bf16x8*)(kp + 16 * kk); } }
#pragma unroll
        for (int q = 0; q < 2; ++q) { if (q == 1 && !two) break; const int unit = q ? u1 : unit0;
            f32x16 acc;
#pragma unroll
            for (int i = 0; i < 16; ++i) acc[i] = 0.f;
#pragma unroll
            for (int kk = 0; kk < 8; ++kk) acc = __builtin_amdgcn_mfma_f32_32x32x16_bf16(vf[q][kk], kf[q][kk], acc, 0, 0, 0);
            float* op = KVT + (size_t)unit * 8192 + (size_t)(32 * es + 4 * hh) * 64 + 32 * ds + r;
#pragma unroll
            for (int i = 0; i < 16; ++i) op[(size_t)((i & 3) + 8 * (i >> 2)) * 64] = acc[i]; }
    }
}
__device__ __forceinline__ void ret_chunk_item(LAS unsigned char* lds, int b, int hd, int n, const bf16_t* proj, const bf16_t* VT, const float* KVT, bf16_t* Y) {
    constexpr int NKS = 4, NES = 4, KP = 144, VP = 272, SP = 144;
    constexpr int KBYTES = 128 * KP, ST_OFF = 65536;
    int tid_ = threadIdx.x; asm volatile("" : "+v"(tid_));
    const int tid = tid_, lane = tid & 63, wid = __builtin_amdgcn_readfirstlane(tid >> 6), r = lane & 31, hh = lane >> 5, kh = wid >> 2;
    const int Q0 = n * 128 + (wid & 3) * 32, query = Q0 + r; const size_t qrow = (size_t)b * SEQ + query;
    const float lg2 = __log2f(1.0f - exp2f(-(float)(5 + hd)));
    {
        const bf16_t* gk = proj + ((size_t)b * SEQ + 128 * n + (tid >> 3)) * 1024 + 256 + hd * 64 + (tid & 7) * 8;
        const bf16_t* gv = VT + ((size_t)(b * 4 + hd) * 128 + (tid >> 4)) * SEQ + 128 * n + (tid & 15) * 8;
        const unsigned lk = (tid >> 3) * KP + (tid & 7) * 16, lv = KBYTES + (tid >> 4) * VP + (tid & 15) * 16;
        u32x4 ck[2], cv[4];
#pragma unroll
        for (int i = 0; i < 2; ++i) ck[i] = *(const u32x4*)(gk + (size_t)(64 * i) * 1024);
#pragma unroll
        for (int i = 0; i < 4; ++i) cv[i] = *(const u32x4*)(gv + (size_t)(32 * i) * SEQ);
        f32x4 sa[4];
#pragma unroll
        for (int i = 0; i < 4; ++i) sa[i] = (f32x4){0.f, 0.f, 0.f, 0.f};
        const float* kb = KVT + ((size_t)(b * 4 + hd) * 16) * 8192 + tid * 16;
        for (int m0 = 0; m0 < n; m0 += 8) {
            f32x4 pv[8][4]; float w[8];
#pragma unroll
            for (int j = 0; j < 8; ++j) { const int m = m0 + j, mc = m < n ? m : n - 1; const f32x4* p = (const f32x4*)(kb + (size_t)mc * 8192);
                w[j] = m < n ? fast_exp2((float)(128 * (n - 1 - m)) * lg2) : 0.f;
#pragma unroll
                for (int i = 0; i < 4; ++i) pv[j][i] = p[i]; }
#pragma unroll
            for (int j = 0; j < 8; ++j)
#pragma unroll
                for (int i = 0; i < 4; ++i) sa[i] += pv[j][i] * w[j];
        }
        *(LAS u32x4*)(lds + ST_OFF + (tid >> 2) * SP + (tid & 3) * 32) = pack8(sa[0], sa[1]);
        *(LAS u32x4*)(lds + ST_OFF + (tid >> 2) * SP + (tid & 3) * 32 + 16) = pack8(sa[2], sa[3]);
#pragma unroll
        for (int i = 0; i < 2; ++i) *(LAS u32x4*)(lds + lk + 64 * i * KP) = ck[i];
#pragma unroll
        for (int i = 0; i < 4; ++i) *(LAS u32x4*)(lds + lv + 32 * i * VP) = cv[i];
    }
    bf16x8 qf[NKS];
#pragma unroll
    for (int ks = 0; ks < NKS; ++ks) qf[ks] = *(const bf16x8*)(proj + qrow * 1024 + hd * 64 + ks * 16 + hh * 8);
    f32x16 o[NES];
#pragma unroll
    for (int e = 0; e < NES; ++e)
#pragma unroll
        for (int i = 0; i < 16; ++i) o[e][i] = 0.f;
    __syncthreads();
    const int tile = 2 * n + kh, my_last = Q0 >> 6;
    if (tile <= my_last) {
        f32x16 s[2];
        {
            bf16x8 kf[2][NKS];
#pragma unroll
            for (int sub = 0; sub < 2; ++sub)
#pragma unroll
                for (int ks = 0; ks < NKS; ++ks) kf[sub][ks] = *(const LAS bf16x8*)(lds + (64 * kh + 32 * sub + r) * KP + ks * 32 + hh * 16);
#pragma unroll
            for (int sub = 0; sub < 2; ++sub)
#pragma unroll
                for (int i = 0; i < 16; ++i) s[sub][i] = 0.f;
            __builtin_amdgcn_sched_barrier(0);
#pragma unroll
            for (int ks = 0; ks < NKS; ++ks)
#pragma unroll
                for (int sub = 0; sub < 2; ++sub) s[sub] = __builtin_amdgcn_mfma_f32_32x32x16_bf16(kf[sub][ks], qf[ks], s[sub], 0, 0, 0);
        }
        const int kbase = 64 * tile + 4 * hh;
#pragma unroll
        for (int sub = 0; sub < 2; ++sub)
#pragma unroll
            for (int i = 0; i < 16; ++i) { const int key = kbase + 32 * sub + (i & 3) + 8 * (i >> 2); s[sub][i] = (key > query) ? 0.f : s[sub][i] * fast_exp2((float)(query - key) * lg2); }
        bf16x8 pf[2][2];
#pragma unroll
        for (int sub = 0; sub < 2; ++sub)
#pragma unroll
            for (int s2 = 0; s2 < 2; ++s2) { u32x4 w; w.x = cvt_pk_bf16(s[sub][8 * s2 + 0], s[sub][8 * s2 + 1]); w.y = cvt_pk_bf16(s[sub][8 * s2 + 2], s[sub][8 * s2 + 3]);
                w.z = cvt_pk_bf16(s[sub][8 * s2 + 4], s[sub][8 * s2 + 5]); w.w = cvt_pk_bf16(s[sub][8 * s2 + 6], s[sub][8 * s2 + 7]); pf[sub][s2] = __builtin_bit_cast(bf16x8, w); }
#pragma unroll
        for (int ep = 0; ep < NES; ep += 2) {
            bf16x8 vf[2][4];
#pragma unroll
            for (int e = 0; e < 2; ++e)
#pragma unroll
                for (int kk = 0; kk < 4; ++kk) vf[e][kk] = *(const LAS bf16x8*)(lds + KBYTES + (32 * (ep + e) + r) * VP + (4 * kh + kk) * 32 + hh * 16);
            __builtin_amdgcn_sched_barrier(0);
#pragma unroll
            for (int kk = 0; kk < 4; ++kk)
#pragma unroll
                for (int e = 0; e < 2; ++e) o[ep + e] = __builtin_amdgcn_mfma_f32_32x32x16_bf16(vf[e][kk], pf[kk >> 1][kk & 1], o[ep + e], 0, 0, 0);
        }
    }
    if (n > 0) {
        f32x16 oc[2];
#pragma unroll
        for (int e = 0; e < 2; ++e)
#pragma unroll
            for (int i = 0; i < 16; ++i) oc[e][i] = 0.f;
        bf16x8 sf[2][NKS];
#pragma unroll
        for (int e = 0; e < 2; ++e)
#pragma unroll
            for (int ks = 0; ks < NKS; ++ks) sf[e][ks] = *(const LAS bf16x8*)(lds + ST_OFF + (32 * (2 * kh + e) + r) * SP + ks * 32 + hh * 16);
#pragma unroll
        for (int ks = 0; ks < NKS; ++ks)
#pragma unroll
            for (int e = 0; e < 2; ++e) oc[e] = __builtin_amdgcn_mfma_f32_32x32x16_bf16(sf[e][ks], qf[ks], oc[e], 0, 0, 0);
        const float f = fast_exp2((float)((query & 127) + 1) * lg2);
        if (kh == 0) {
#pragma unroll
            for (int e = 0; e < 2; ++e)
#pragma unroll
                for (int i = 0; i < 16; ++i) o[e][i] += f * oc[e][i];
        } else {
#pragma unroll
            for (int e = 0; e < 2; ++e)
#pragma unroll
                for (int i = 0; i < 16; ++i) o[2 + e][i] += f * oc[e][i];
        }
    }
    __syncthreads();
    LAS float* X = (LAS float*)lds;
    if (kh == 1) {
#pragma unroll
        for (int e = 0; e < NES; ++e)
#pragma unroll
            for (int i = 0; i < 16; ++i) X[((wid & 3) * 64 + e * 16 + i) * 64 + lane] = o[e][i];
    }
    __syncthreads();
    if (kh == 0) {
#pragma unroll
        for (int e = 0; e < NES; ++e)
#pragma unroll
            for (int i = 0; i < 16; ++i) o[e][i] += X[((wid & 3) * 64 + e * 16 + i) * 64 + lane];
        float s1 = 0.f;
#pragma unroll
        for (int e = 0; e < NES; ++e)
#pragma unroll
            for (int i = 0; i < 16; ++i) s1 += o[e][i];
        const float mean = (s1 + __shfl_xor(s1, 32)) * (1.0f / 128.0f); float s2 = 0.f;
#pragma unroll
        for (int e = 0; e < NES; ++e)
#pragma unroll
            for (int i = 0; i < 16; ++i) { o[e][i] -= mean; s2 += o[e][i] * o[e][i]; }
        const float rstd = __builtin_amdgcn_rsqf((s2 + __shfl_xor(s2, 32)) * (1.0f / 128.0f) + EPS);
        const bf16_t* gp = proj + qrow * 1024 + 512 + hd * 128 + 4 * hh; bf16_t* yp = Y + qrow * 2048 + 512 + hd * 128 + 4 * hh;
#pragma unroll
        for (int e = 0; e < NES; ++e)
#pragma unroll
            for (int g = 0; g < 4; ++g) { const u32x2 gw = *(const u32x2*)(gp + 32 * e + 8 * g);
                u32x2 w; w.x = cvt_pk_bf16(o[e][4 * g] * rstd * bflo(gw.x), o[e][4 * g + 1] * rstd * bfhi(gw.x)); w.y = cvt_pk_bf16(o[e][4 * g + 2] * rstd * bflo(gw.y), o[e][4 * g + 3] * rstd * bfhi(gw.y)); *(u32x2*)(yp + 32 * e + 8 * g) = w; }
    }
    __syncthreads();
}
__device__ __forceinline__ void ret_chunk_phase(LAS unsigned char* lds, const bf16_t* proj, const bf16_t* RVT, const float* KVT, bf16_t* Y) {
    for (int pr = blockIdx.x; pr < 256; pr += gridDim.x) { const int bh = pr >> 3, p = pr & 7;
        ret_chunk_item(lds, bh >> 2, bh & 3, 15 - p, proj, RVT, KVT, Y);
        ret_chunk_item(lds, bh >> 2, bh & 3, p, proj, RVT, KVT, Y); }
}

__device__ __forceinline__ void final_norm(float* out, const float* ssq, const float* gfin) {
    int tid_ = threadIdx.x; asm volatile("" : "+v"(tid_));
    const int lane = tid_ & 63, wave = tid_ >> 6, nw = gridDim.x * 8;
    const f32x4* gr = (const f32x4*)gfin + lane; f32x4 gv[4];
#pragma unroll
    for (int j = 0; j < 4; ++j) gv[j] = gr[64 * j];
    for (int m0 = blockIdx.x * 8 + wave; m0 < MTOT; m0 += 2 * nw) {
        const int m1 = m0 + nw; const bool two = m1 < MTOT;
        f32x4* xa = (f32x4*)(out + (size_t)m0 * 1024) + lane; f32x4* xb2 = (f32x4*)(out + (size_t)(two ? m1 : m0) * 1024) + lane;
        f32x4 va[4], vb[4];
#pragma unroll
        for (int j = 0; j < 4; ++j) { va[j] = xa[64 * j]; vb[j] = xb2[64 * j]; }
        const float ra = rstd16(ssq + (size_t)m0 * 16, 1.0f / 1024.0f), rb = rstd16(ssq + (size_t)(two ? m1 : m0) * 16, 1.0f / 1024.0f);
#pragma unroll
        for (int j = 0; j < 4; ++j) xa[64 * j] = va[j] * ra * gv[j];
        if (two) {
#pragma unroll
            for (int j = 0; j < 4; ++j) xb2[64 * j] = vb[j] * rb * gv[j]; }
    }
}

#define XB_TMO      128
#define XB_XCNT(j)  (256  + 64 * (j))
#define XB_XSUB(j)  (1280 + 64 * (j))
#define XB_XGEN(j)  (2304 + 64 * (j))
#define XB_TOP      3328
#define XB_TOPGEN   3392
#define XCD_BAR_WORDS 3456
#define XB_SPIN_CAP (1u << 20)
__device__ __forceinline__ unsigned xb_ld(unsigned* p)              { return __hip_atomic_load(p, __ATOMIC_RELAXED, __HIP_MEMORY_SCOPE_AGENT); }
__device__ __forceinline__ unsigned xb_add(unsigned* p, unsigned v) { return __hip_atomic_fetch_add(p, v, __ATOMIC_RELAXED, __HIP_MEMORY_SCOPE_AGENT); }
__device__ __forceinline__ unsigned xb_xcc_id() { return (unsigned)__builtin_amdgcn_s_getreg((3 << 11) | 20) & 0xFu; }
#define XB_SPIN(cond, bar) do { unsigned _sp = 0; while (cond) { __builtin_amdgcn_s_sleep(1); \
    if ((++_sp & 255u) == 0u) { if (xb_ld(&(bar)[XB_TMO])) break; if (_sp > XB_SPIN_CAP) { atomicAdd(&(bar)[XB_TMO], 1u); break; } } } } while (0)
struct XcdBarrier { unsigned* bar; unsigned x; volatile LAS unsigned* st; };
__device__ __forceinline__ XcdBarrier xcd_barrier_post(unsigned* bar, volatile LAS unsigned* st) {
    XcdBarrier b; b.bar = bar; b.x = xb_xcc_id(); b.st = st;
    if (threadIdx.x == 0) (void)xb_add(&bar[XB_XCNT(b.x)], 1u);
    return b;
}
__device__ __forceinline__ void xcd_barrier_complete(unsigned* bar, unsigned x, unsigned& nloc, unsigned& nx) {
    const unsigned G = gridDim.x * gridDim.y * gridDim.z;
    unsigned sum, cnt, mine, sp = 0u;
    for (;;) {
        sum = 0u; cnt = 0u; mine = 0u;
#pragma unroll
        for (unsigned j = 0; j < 16; ++j) { const unsigned c = xb_ld(&bar[XB_XCNT(j)]); sum += c; cnt += (c > 0u) ? 1u : 0u; mine = (j == x) ? c : mine; }
        if (sum == G) break;
        __builtin_amdgcn_s_sleep(1);
        if ((++sp & 255u) == 0u) { if (xb_ld(&bar[XB_TMO])) break; if (sp > XB_SPIN_CAP) { atomicAdd(&bar[XB_TMO], 1u); break; } }
    }
    nloc = mine > 0u ? mine : 1u; nx = cnt > 0u ? cnt : 1u;
}
__device__ __forceinline__ void xcd_barrier(const XcdBarrier& b) {
    asm volatile("s_waitcnt vmcnt(0)" ::: "memory");
    __syncthreads();
    if (threadIdx.x == 0) {
        unsigned* bar = b.bar;
        __builtin_amdgcn_s_waitcnt(0);
        unsigned nloc = b.st[0], nx = b.st[1];
        if (nloc == 0u) { xcd_barrier_complete(bar, b.x, nloc, nx); b.st[0] = nloc; b.st[1] = nx; }
        const unsigned old = xb_add(&bar[XB_XSUB(b.x)], 1u);
        const unsigned gen = old / nloc;
        if (old + 1u == (gen + 1u) * nloc) {
            __builtin_amdgcn_fence(__ATOMIC_RELEASE, "agent");
            asm volatile("s_waitcnt vmcnt(0)" ::: "memory");
            const unsigned og = xb_add(&bar[XB_TOP], 1u);
            const unsigned tg = og / nx;
            if (og + 1u == (tg + 1u) * nx) xb_add(&bar[XB_TOPGEN], 1u);
            else XB_SPIN(xb_ld(&bar[XB_TOPGEN]) == tg, bar);
            __builtin_amdgcn_fence(__ATOMIC_ACQUIRE, "agent");
            xb_add(&bar[XB_XGEN(b.x)], 1u);
            asm volatile("s_waitcnt vmcnt(0)" ::: "memory");
        } else {
            XB_SPIN(xb_ld(&bar[XB_XGEN(b.x)]) == gen, bar);
            __builtin_amdgcn_fence(__ATOMIC_ACQUIRE, "agent");
            asm volatile("s_waitcnt vmcnt(0)" ::: "memory");
        }
    }
    __syncthreads();
}

constexpr int LDS_BYTES = 147456;
#ifdef PROBE_SYNC
#define GSYNC() do { xcd_barrier(xbar); xcd_barrier(xbar); } while (0)
#else
#define GSYNC() xcd_barrier(xbar)
#endif
__global__ void __launch_bounds__(512, 2) fwd_kernel(Args a) {
    extern __shared__ __attribute__((aligned(16))) unsigned char lds_raw[];
    LAS unsigned char* lds = (LAS unsigned char*)lds_raw;
    cg::grid_group grid = cg::this_grid();
    unsigned char* ws = a.ws;
    volatile LAS unsigned* xst = (volatile LAS unsigned*)(lds + XST_OFF);
    if (threadIdx.x < 4) xst[threadIdx.x] = 0u;
    if (blockIdx.x == 0) { unsigned* bw = (unsigned*)(ws + OFF_BAR); for (int i = threadIdx.x; i < XCD_BAR_WORDS; i += 512) bw[i] = 0u; }
    __syncthreads();

#ifndef SKIP_P0
    p0_prep(a, lds);
#ifdef PROBE_P0
    __syncthreads(); p0_prep(a, lds);
#endif
#endif

    grid.sync();
    const XcdBarrier xbar = xcd_barrier_post((unsigned*)(ws + OFF_BAR), xst);
    bf16_t* Wb = (bf16_t*)(ws + OFF_W);
    float* tmc0 = (float*)(ws + OFF_TAB); float* tms0 = tmc0 + (size_t)MTOT * 16; float* trc0 = tms0 + (size_t)MTOT * 16; float* trs0 = trc0 + (size_t)MTOT * 32;
    bf16_t* PROJ = (bf16_t*)(ws + OFF_PG); bf16_t* G = (bf16_t*)(ws + OFF_PG); bf16_t* ACT = (bf16_t*)(ws + OFF_PG);
    bf16_t* CQ = (bf16_t*)(ws + OFF_CQ); bf16_t* CKV = (bf16_t*)(ws + OFF_CKV); float* SQQ = (float*)(ws + OFF_SQQ); float* SQKV = (float*)(ws + OFF_SQKV);
    bf16_t* Qb = (bf16_t*)(ws + OFF_Q); bf16_t* KVb = (bf16_t*)(ws + OFF_KV); bf16_t* Y = (bf16_t*)(ws + OFF_Y); bf16_t* MERGED = (bf16_t*)(ws + OFF_KV); bf16_t* VTb = KVb + (size_t)MH * 512; bf16_t* RVT = (bf16_t*)(ws + OFF_RVT); bf16_t* RKT = (bf16_t*)(ws + OFF_RKT); float* KVT = (float*)(ws + OFF_KVT); bf16_t* RQKG = (bf16_t*)(ws + OFF_RQKG);
    for (int l = 0; l < NLAYER; ++l) {
        const bf16_t* WL = Wb + (size_t)l * WL_ELEMS;
        for (int half = 0; half < 2; ++half) {
            const size_t R0 = (size_t)half * MH;
            bf16_t* XB = (bf16_t*)(ws + OFF_XB) + R0 * 1024; float* SSQ = (float*)(ws + OFF_SSQ) + R0 * 16;
            const float* tmc = tmc0 + R0 * 16; const float* tms = tms0 + R0 * 16; const float* trc = trc0 + R0 * 32; const float* trs = trs0 + R0 * 32;
            float* XO = a.out + R0 * 1024;

#ifndef SKIP_INA
            { EpiInA E{SSQ, (const LAS float*)(lds + SPARE_OFF), PROJ, CQ, CKV, SQQ, SQKV, trc, trs, tmc, tms, RVT, RKT, RQKG}; run_gemm(lds, XB, 1024, WL + WO_INA, 1024, 1024, NA_PHYS, E); }
            if (l == 0) tail_convert(a, lds, 2 * half);
#ifdef PROBE_INA
            { EpiInA E{SSQ, (const LAS float*)(lds + SPARE_OFF), PROJ, CQ, CKV, SQQ, SQKV, trc, trs, tmc, tms, RVT, RKT, RQKG}; run_gemm(lds, XB, 1024, WL + WO_INA, 1024, 1024, NA_PHYS, E); }
#endif
#endif

            GSYNC();

#ifndef SKIP_UQ
            { EpiUpQ E{SQQ, tmc, tms, Qb}; run_gemm(lds, CQ, 512, WL + WO_UQ, 384, 384, 768, E); }
            if (l == 0) tail_convert(a, lds, 2 * half + 1);
#endif


#ifndef SKIP_UKV
            { EpiUpKV E{SQKV, KVb, VTb}; run_gemm(lds, CKV, 256, WL + WO_UKV, 256, 256, 1024, E); }
#endif


#ifndef SKIP_CONV
            conv_phase(PROJ, a.in[5] + (size_t)l * 3 * 512, Y);
#endif

            __syncthreads();

#ifndef SKIP_SG
            sg_phase2(lds, PROJ, a.in[6] + l * 512, a.in[7] + l * 512, a.in[8] + (size_t)l * 4 * 128 * 128, a.in[9] + l * 4 * 128, Y);
#ifdef PROBE_SG
            sg_phase2(lds, PROJ, a.in[6] + l * 512, a.in[7] + l * 512, a.in[8] + (size_t)l * 4 * 128 * 128, a.in[9] + l * 4 * 128, Y);
#endif
#endif


#ifndef SKIP_RET
            __syncthreads();
            kvt_phase(RVT, RKT, KVT);
#endif

            GSYNC();

#ifndef SKIP_RET
            ret_chunk_phase(lds, RQKG, RVT, KVT, Y);
#ifdef PROBE_RET
            ret_chunk_phase(lds, RQKG, RVT, KVT, Y);
#endif
#endif
#ifndef SKIP_ATT
            attn_phase(lds, Qb, KVb, CQ, VTb, Y);
#ifdef PROBE_ATT
            attn_phase(lds, Qb, KVb, CQ, VTb, Y);
#endif
#endif

            __syncthreads();

#ifndef SKIP_GATE
            { EpiGate E{SSQ, a.in[4] + (size_t)l * 4 * 1024, (const LAS float*)(lds + SPARE_OFF), (const LAS float*)(lds + BL_OFF), G}; run_gemm(lds, XB, 1024, WL + WO_GATE, 1024, 1024, 4096, E); }
#ifdef PROBE_GATE
            { EpiGate E{SSQ, a.in[4] + (size_t)l * 4 * 1024, (const LAS float*)(lds + SPARE_OFF), (const LAS float*)(lds + BL_OFF), G}; run_gemm(lds, XB, 1024, WL + WO_GATE, 1024, 1024, 4096, E); }
#endif
#endif

            GSYNC();

#ifndef SKIP_MERGED
            { EpiMerged E{G, MERGED}; run_gemm(lds, Y, 2048, WL + WO_BR, 2048, 2048, 1024, E); }
#ifdef PROBE_MERGED
            { EpiMerged E{G, MERGED}; run_gemm(lds, Y, 2048, WL + WO_BR, 2048, 2048, 1024, E); }
#endif
#endif

            GSYNC();

#ifndef SKIP_WOUT
            if (l == 0) { EpiRes<true, false> E{a.in[0] + R0 * 1024, nullptr, XB, SSQ}; run_gemm(lds, MERGED, 1024, WL + WO_OUT, 1024, 1024, 1024, E); }
            else { EpiRes<false, false> E{nullptr, nullptr, XB, SSQ}; run_gemm(lds, MERGED, 1024, WL + WO_OUT, 1024, 1024, 1024, E); }
#endif

            if (half == 1) GSYNC();
        }
        {
            bf16_t* XB = (bf16_t*)(ws + OFF_XB); float* SSQ = (float*)(ws + OFF_SSQ); float* XO = a.out;
#ifndef SKIP_FI
            { EpiFfnIn E{SSQ, (const LAS float*)(lds + SPARE_OFF), ACT}; run_gemm(lds, XB, 1024, WL + WO_FI, 1024, 1024, 2 * DFF, E, MTOT); }
#ifdef PROBE_FI
            { EpiFfnIn E{SSQ, (const LAS float*)(lds + SPARE_OFF), ACT}; run_gemm(lds, XB, 1024, WL + WO_FI, 1024, 1024, 2 * DFF, E, MTOT); }
#endif
#endif
            GSYNC();
#ifndef SKIP_FO
            if (l + 1 < NLAYER) { EpiRes<false, false> E{nullptr, nullptr, XB, SSQ}; run_gemm(lds, ACT, DFF, WL + WO_FO, DFF, DFF, 1024, E, MTOT); }
            else { EpiRes<false, true> E{nullptr, XO, XB, SSQ}; run_gemm(lds, ACT, DFF, WL + WO_FO, DFF, DFF, 1024, E, MTOT); }
#endif
            GSYNC();
        }
    }
    final_norm(a.out, (const float*)(ws + OFF_SSQ), a.in[19]);
}

extern "C" void kernel_launch(void* const* d_in, const int* in_sizes, int n_in, void* d_out, int out_size, void* d_ws, size_t ws_size, hipStream_t stream) {
    static int grid = 0;
    if (!grid) {
        int dev = 0, cus = 0, per_cu = 0;
        (void)hipGetDevice(&dev);
        (void)hipDeviceGetAttribute(&cus, hipDeviceAttributeMultiprocessorCount, dev);
        (void)hipFuncSetAttribute((const void*)fwd_kernel, hipFuncAttributeMaxDynamicSharedMemorySize, LDS_BYTES);
        (void)hipOccupancyMaxActiveBlocksPerMultiprocessor(&per_cu, fwd_kernel, 512, LDS_BYTES);
        grid = cus > 0 ? cus : 256;
        if (ws_size < OFF_END) fprintf(stderr, "kernel_launch: workspace too small: %zu < %zu\n", ws_size, (size_t)OFF_END);
        fprintf(stderr, "kernel_launch: cus %d per_cu %d grid %d n_in %d\n", cus, per_cu, grid, n_in);
    }
    Args a{};
    for (int i = 0; i < 20; ++i) a.in[i] = (const float*)d_in[i];
    a.out = (float*)d_out; a.ws = (unsigned char*)d_ws;
    void* args[] = {&a};
    hipError_t e = hipLaunchCooperativeKernel((void*)fwd_kernel, dim3(grid), dim3(512), args, LDS_BYTES, stream);
    if (e != hipSuccess) fprintf(stderr, "kernel_launch: cooperative launch failed: %s\n", hipGetErrorString(e));
}
```

```cpp
#include <hip/hip_runtime.h>
#include <hip/hip_cooperative_groups.h>
#include <cstdio>
#include <cstdint>
namespace cg = cooperative_groups;

#define LAS __attribute__((address_space(3)))
#define PG8_LAS __attribute__((address_space(3)))
typedef unsigned short bf16_t;
typedef short bf16x8 __attribute__((ext_vector_type(8)));
typedef float f32x4 __attribute__((ext_vector_type(4)));
typedef float f32x2 __attribute__((ext_vector_type(2)));
typedef unsigned u32x4 __attribute__((ext_vector_type(4)));
typedef unsigned u32x2 __attribute__((ext_vector_type(2)));

constexpr int DM = 1024, SEQ = 2048, NBATCH = 16, MTOT = NBATCH * SEQ, MH = MTOT / 2, NIN = 8864, DFF = 2816, NLAYER = 2;
constexpr int LDP = 3584;
constexpr int PC_AB = 0, PC_CX = 512, PC_RQ = 1024, PC_RK = 1280, PC_RV = 1536, PC_RG = 2048, PC_SU = 2560, PC_SV = 3072;
constexpr int NA_PHYS = 4864;
constexpr float EPS = 1e-6f;
constexpr float QSCALE = 0.10206207261596577f * 1.4426950408889634f;

__device__ __forceinline__ float bf2f(unsigned b) { return __uint_as_float(b << 16); }
__device__ __forceinline__ float bflo(unsigned w) { return __uint_as_float(w << 16); }
__device__ __forceinline__ float bfhi(unsigned w) { return __uint_as_float(w & 0xffff0000u); }
typedef __bf16 bf16x2_t __attribute__((ext_vector_type(2)));
__device__ __forceinline__ unsigned cvt_pk_bf16(float lo, float hi) { const f32x2 v = {lo, hi}; return __builtin_bit_cast(unsigned, __builtin_convertvector(v, bf16x2_t)); }
__device__ __forceinline__ unsigned f2bf(float f) { unsigned u = __float_as_uint(f); return (u + 0x7fffu + ((u >> 16) & 1u)) >> 16; }
__device__ __forceinline__ float fast_exp2(float x) { return __builtin_amdgcn_exp2f(x); }
__device__ __forceinline__ float fast_rcp(float x) { return __builtin_amdgcn_rcpf(x); }
__device__ __forceinline__ float sigmoidf_(float x) { return fast_rcp(1.0f + fast_exp2(-1.4426950408889634f * x)); }
__device__ __forceinline__ float siluf_(float x) { return x * sigmoidf_(x); }
__device__ __forceinline__ float geluf_(float x) { const float u = 0.7978845608028654f * (x + 0.044715f * x * x * x); return x * sigmoidf_(2.0f * u); }
__device__ __forceinline__ f32x4 sigmoid4(const f32x4 x) { const f32x4 t = x * (-1.4426950408889634f); f32x4 e; e[0] = fast_exp2(t[0]); e[1] = fast_exp2(t[1]); e[2] = fast_exp2(t[2]); e[3] = fast_exp2(t[3]);
    const f32x4 d = e + 1.0f; f32x4 r; r[0] = fast_rcp(d[0]); r[1] = fast_rcp(d[1]); r[2] = fast_rcp(d[2]); r[3] = fast_rcp(d[3]); return r; }
__device__ __forceinline__ f32x4 silu4(const f32x4 x) { return x * sigmoid4(x); }
__device__ __forceinline__ f32x4 gelu4(const f32x4 x) { const f32x4 u = (x * x * 0.044715f + 1.0f) * x * (2.0f * 0.7978845608028654f); return x * sigmoid4(u); }
__device__ __forceinline__ float wave_sum(float v) {
#pragma unroll
    for (int o = 1; o < 64; o <<= 1) v += __shfl_xor(v, o);
    return v;
}

namespace pg8 {
constexpr int BM = 256, BK = 64, HALF = 128, HTB = HALF * BK * 2, STAGE_BYTES = 8 * HTB, NXCD = 8, WGM = 8;
__host__ __device__ __forceinline__ int lds_byte(int r, int c) { const int st = (r >> 4) * 2 + (c >> 5), rr = r & 15, cc = c & 31, ob = rr * 64 + cc * 2; return st * 1024 + (ob ^ (((ob >> 9) & 1) << 5)); }
__host__ __device__ __forceinline__ void stage_rc(int b, int& R, int& C) { const int st = b / 1024, sb = b % 1024, swz = sb ^ (((sb >> 9) & 1) << 5); R = (st >> 1) * 16 + swz / 64; C = (st & 1) * 32 + (swz % 64) / 2; }
__host__ __device__ __forceinline__ int perm32(int rho) { const int n = rho >> 4, i = rho & 15; return 8 * (i >> 2) + 4 * n + (i & 3); }
struct Unit { int pm, pn, idx; };
struct Gemm { const bf16_t* A; const bf16_t* Bt; int lda, ldb, K; };
struct StaticOrder {
    int nM, nN, nwg, G, c;
    __host__ __device__ void init(int M, int N, int G_, int c_) { nM = M / BM; nN = N / BM; nwg = nM * nN; G = G_; c = c_; }
    __host__ __device__ bool next(int i, Unit& u) const {
        const long L = (long)i * G + c; if (L >= nwg) return false;
        int wgid = (int)L; { const int q = nwg / NXCD, r = nwg % NXCD, xcd = wgid % NXCD, off = wgid / NXCD; wgid = (xcd < r ? xcd * (q + 1) : r * (q + 1) + (xcd - r) * q) + off; }
        const int nig = WGM * nN, gid = wgid / nig, fm = gid * WGM, gsz = (nM - fm) < WGM ? (nM - fm) : WGM;
        u.pm = fm + ((wgid % nig) % gsz); u.pn = (wgid % nig) / gsz; u.idx = i; return true;
    }
    __device__ __forceinline__ void a_ready(const Unit&) const {}
    __device__ __forceinline__ void done(const Unit&) const {}
};
template <class Epi, class Sched, bool ALIGN_EPI = false, bool SP2 = false>
__device__ __forceinline__ void gemm_phase(PG8_LAS unsigned char* lds, const Gemm g, const Sched& S, const Epi& E) {
    int tid_ = threadIdx.x; asm volatile("" : "+v"(tid_));
    const int tid = tid_, wid = __builtin_amdgcn_readfirstlane(tid >> 6), lane = tid & 63, wr = wid >> 2, wc = wid & 3, fr = lane & 15, fq = lane >> 4;
    const int K = g.K, nt = K / BK;
    unsigned voffA[2], voffB[2];
#pragma unroll
    for (int i = 0; i < 2; ++i) { int R, C; stage_rc(tid * 16 + i * 8192, R, C); const int Rb = Epi::PERM ? ((R & ~31) + perm32(R & 31)) : R;
        voffA[i] = (unsigned)(R * g.lda + C) * 2u; voffB[i] = (unsigned)(Rb * g.ldb + C) * 2u; }
    const size_t kstep = (size_t)(BK * 2);
    const size_t hstepA = (size_t)HALF * g.lda * 2, hstepB = (size_t)HALF * g.ldb * 2;
    const size_t tstepA = 2 * hstepA, tstepB = 2 * hstepB;
    const unsigned ldsw = (unsigned)wid * 1024u;
    const int aoff = lds_byte(wr * 64 + fr, fq * 8), boff = lds_byte(wc * 32 + fr, fq * 8);
#define PG8_SA(b, h) (((b) * 2 + (h)) * HTB)
#define PG8_SB(b, h) ((4 + (b) * 2 + (h)) * HTB)
#define PG8_STAGE(bufoff, gbase, voff) do { _Pragma("unroll") for (int _i = 0; _i < 2; ++_i) \
        __builtin_amdgcn_global_load_lds((const unsigned*)((const char*)(gbase) + (voff)[_i]), (PG8_LAS unsigned*)(lds + (bufoff) + ldsw + _i * 8192), 16, 0, 0); } while (0)
#define PG8_LDA(dst, b, h) do { _Pragma("unroll") for (int m = 0; m < 4; ++m) _Pragma("unroll") for (int k = 0; k < 2; ++k) dst[m][k] = *(const PG8_LAS bf16x8*)(lds + PG8_SA(b, h) + aoff + m * 2048 + k * 1024); } while (0)
#define PG8_LDB(dst, b, h) do { _Pragma("unroll") for (int n = 0; n < 2; ++n) _Pragma("unroll") for (int k = 0; k < 2; ++k) dst[n][k] = *(const PG8_LAS bf16x8*)(lds + PG8_SB(b, h) + boff + n * 2048 + k * 1024); } while (0)
#define PG8_MMA(ai, bj, At, Bt) do { __builtin_amdgcn_s_setprio(1); _Pragma("unroll") for (int m = 0; m < 4; ++m) _Pragma("unroll") for (int n = 0; n < 2; ++n) _Pragma("unroll") for (int k = 0; k < 2; ++k) \
        acc[ai][bj][m][n] = __builtin_amdgcn_mfma_f32_16x16x32_bf16(Bt[n][k], At[m][k], acc[ai][bj][m][n], 0, 0, 0); __builtin_amdgcn_s_setprio(0); } while (0)
#define PG8_WAIT_V(n) asm volatile("s_waitcnt vmcnt(" #n ")" ::: "memory")
#define PG8_WAIT_L(n) asm volatile("s_waitcnt lgkmcnt(" #n ")" ::: "memory")
#define PG8_BAR __builtin_amdgcn_s_barrier()
#define PG8_SCHED __builtin_amdgcn_sched_barrier(0)
    Unit cur, nxt; int ui = 0;
    if (!S.next(0, cur)) return;
    f32x4 acc[2][2][4][2];
#pragma unroll
    for (int a = 0; a < 2; ++a)
#pragma unroll
        for (int b = 0; b < 2; ++b)
#pragma unroll
            for (int m = 0; m < 4; ++m)
#pragma unroll
                for (int n = 0; n < 2; ++n) acc[a][b][m][n] = (f32x4){0.f, 0.f, 0.f, 0.f};
    bf16x8 At[4][2], B0[2][2], B1[2][2];
    const char* cA = (const char*)g.A + (size_t)cur.pm * tstepA; const char* cB = (const char*)g.Bt + (size_t)cur.pn * tstepB;
    S.a_ready(cur);
    if constexpr (SP2) {
        PG8_STAGE(PG8_SB(0, 0), cB, voffB); PG8_STAGE(PG8_SB(0, 1), cB + hstepB, voffB); PG8_STAGE(PG8_SA(0, 0), cA, voffA); PG8_STAGE(PG8_SA(0, 1), cA + hstepA, voffA);
        if (wr == 1) PG8_BAR;
        PG8_WAIT_V(2); PG8_BAR;
        PG8_STAGE(PG8_SB(1, 0), cB + kstep, voffB); PG8_STAGE(PG8_SA(1, 0), cA + kstep, voffA); PG8_STAGE(PG8_SB(1, 1), cB + hstepB + kstep, voffB);
        PG8_WAIT_V(6); PG8_BAR;
    } else {
        PG8_STAGE(PG8_SB(0, 0), cB, voffB); PG8_STAGE(PG8_SA(0, 0), cA, voffA); PG8_STAGE(PG8_SB(0, 1), cB + hstepB, voffB); PG8_STAGE(PG8_SA(0, 1), cA + hstepA, voffA);
        if (wr == 1) PG8_BAR;
        PG8_WAIT_V(4); PG8_BAR;
        PG8_STAGE(PG8_SB(1, 0), cB + kstep, voffB); PG8_STAGE(PG8_SA(1, 0), cA + kstep, voffA); PG8_STAGE(PG8_SB(1, 1), cB + hstepB + kstep, voffB);
        PG8_WAIT_V(6); PG8_BAR;
    }
    for (;;) {
        const bool has_next = S.next(ui + 1, nxt);
        const char* nA = has_next ? (const char*)g.A + (size_t)nxt.pm * tstepA : cA; const char* nB = has_next ? (const char*)g.Bt + (size_t)nxt.pn * tstepB : cB;
        for (int t = 0; t < nt; t += 2) {
            const bool last = (t == nt - 2);
            const char* a1 = cA + (size_t)(t + 1) * kstep;
            const char* a2 = last ? nA : cA + (size_t)(t + 2) * kstep; const char* b2 = last ? nB : cB + (size_t)(t + 2) * kstep;
            const char* a3 = a2 + kstep; const char* b3 = b2 + kstep;
            if (last && has_next) S.a_ready(nxt);
            if constexpr (Epi::SEG) { if (t != 0 && (t & 7) == 0) E.rescale(acc, cur, t >> 3, wr, wc, fr, fq); }
            if constexpr (SP2) {
            PG8_LDB(B0, 0, 0); PG8_LDB(B1, 0, 1); PG8_SCHED; PG8_LDA(At, 0, 0); PG8_STAGE(PG8_SA(1, 1), a1 + hstepA, voffA);
            PG8_WAIT_V(8); PG8_WAIT_L(0); PG8_BAR; PG8_MMA(0, 0, At, B0); PG8_MMA(0, 1, At, B1); PG8_BAR; PG8_SCHED;
            PG8_LDA(At, 0, 1); PG8_STAGE(PG8_SB(0, 0), b2, voffB); PG8_STAGE(PG8_SB(0, 1), b2 + hstepB, voffB); PG8_STAGE(PG8_SA(0, 0), a2, voffA);
            PG8_WAIT_V(8); PG8_WAIT_L(0); PG8_BAR; PG8_MMA(1, 0, At, B0); PG8_MMA(1, 1, At, B1); PG8_BAR; PG8_SCHED;
            PG8_LDB(B0, 1, 0); PG8_LDB(B1, 1, 1); PG8_SCHED; PG8_LDA(At, 1, 0); PG8_STAGE(PG8_SA(0, 1), a2 + hstepA, voffA);
            PG8_WAIT_V(8); PG8_WAIT_L(0); PG8_BAR; PG8_MMA(0, 0, At, B0); PG8_MMA(0, 1, At, B1); PG8_BAR; PG8_SCHED;
            PG8_LDA(At, 1, 1); PG8_STAGE(PG8_SB(1, 0), b3, voffB); PG8_STAGE(PG8_SB(1, 1), b3 + hstepB, voffB); PG8_STAGE(PG8_SA(1, 0), a3, voffA);
            PG8_WAIT_V(8); PG8_WAIT_L(0); PG8_BAR; PG8_MMA(1, 0, At, B0); PG8_MMA(1, 1, At, B1); PG8_BAR; PG8_SCHED;
            } else {
            PG8_LDB(B0, 0, 0); PG8_SCHED; PG8_LDA(At, 0, 0); PG8_STAGE(PG8_SA(1, 1), a1 + hstepA, voffA);
            PG8_WAIT_L(8); PG8_BAR; PG8_WAIT_L(0); PG8_MMA(0, 0, At, B0); PG8_BAR; PG8_SCHED;
            PG8_LDB(B1, 0, 1); PG8_STAGE(PG8_SB(0, 0), b2, voffB);
            PG8_BAR; PG8_WAIT_L(0); PG8_MMA(0, 1, At, B1); PG8_BAR;
            PG8_LDA(At, 0, 1); PG8_STAGE(PG8_SA(0, 0), a2, voffA);
            PG8_BAR; PG8_WAIT_L(0); PG8_MMA(1, 0, At, B0); PG8_BAR; PG8_SCHED;
            PG8_STAGE(PG8_SB(0, 1), b2 + hstepB, voffB);
            PG8_WAIT_V(6); PG8_BAR; PG8_MMA(1, 1, At, B1); PG8_BAR;
            PG8_LDB(B0, 1, 0); PG8_SCHED; PG8_LDA(At, 1, 0); PG8_STAGE(PG8_SA(0, 1), a2 + hstepA, voffA);
            PG8_WAIT_L(8); PG8_BAR; PG8_WAIT_L(0); PG8_MMA(0, 0, At, B0); PG8_BAR; PG8_SCHED;
            PG8_LDB(B1, 1, 1); PG8_STAGE(PG8_SB(1, 0), b3, voffB);
            PG8_BAR; PG8_WAIT_L(0); PG8_MMA(0, 1, At, B1); PG8_BAR;
            PG8_LDA(At, 1, 1); PG8_STAGE(PG8_SA(1, 0), a3, voffA);
            PG8_BAR; PG8_WAIT_L(0); PG8_MMA(1, 0, At, B0); PG8_BAR; PG8_SCHED;
            PG8_STAGE(PG8_SB(1, 1), b3 + hstepB, voffB);
            PG8_WAIT_V(6); PG8_BAR; PG8_MMA(1, 1, At, B1); PG8_BAR;
            }
        }
        if constexpr (ALIGN_EPI) { if (wr == 0) PG8_BAR; }
        if constexpr (!Epi::AFTER_DRAIN) { E(acc, cur, wr, wc, fr, fq); S.done(cur); }
        if (!has_next) break;
#pragma unroll
        for (int a = 0; a < 2; ++a)
#pragma unroll
            for (int b = 0; b < 2; ++b)
#pragma unroll
                for (int m = 0; m < 4; ++m)
#pragma unroll
                    for (int n = 0; n < 2; ++n) acc[a][b][m][n] = (f32x4){0.f, 0.f, 0.f, 0.f};
        cur = nxt; cA = nA; cB = nB; ++ui;
        if constexpr (ALIGN_EPI) { if (wr == 1) PG8_BAR; }
    }
    PG8_WAIT_V(0);
    if constexpr (!ALIGN_EPI) { if (wr == 0) PG8_BAR; }
    PG8_BAR;
    if constexpr (Epi::AFTER_DRAIN) { E.fused(acc, cur, wr, wc, fr, fq, lds, wid, lane); S.done(cur); }
#undef PG8_SA
#undef PG8_SB
#undef PG8_STAGE
#undef PG8_LDA
#undef PG8_LDB
#undef PG8_MMA
#undef PG8_WAIT_V
#undef PG8_WAIT_L
#undef PG8_BAR
#undef PG8_SCHED
}
}

#ifndef PG8_SP2
#define PG8_SP2 true
#endif
#ifndef PG8_ALIGN
#define PG8_ALIGN true
#endif

using pg8::Unit; using pg8::BM; using pg8::HALF;

__device__ __forceinline__ float hsum4(const f32x4 a) { return (a[0] + a[1]) + (a[2] + a[3]); }
__device__ __forceinline__ float hsq4(const f32x4 a) { return (a[0] * a[0] + a[1] * a[1]) + (a[2] * a[2] + a[3] * a[3]); }
__device__ __forceinline__ float rstd16(const float* p, float invn) {
    const f32x4 a = *(const f32x4*)p, b = *(const f32x4*)(p + 4), c = *(const f32x4*)(p + 8), d = *(const f32x4*)(p + 12);
    return __builtin_amdgcn_rsqf(((hsum4(a) + hsum4(b)) + (hsum4(c) + hsum4(d))) * invn + EPS);
}
__device__ __forceinline__ u32x4 pack8(const f32x4 v0, const f32x4 v1) { u32x4 w; w.x = cvt_pk_bf16(v0[0], v0[1]); w.y = cvt_pk_bf16(v0[2], v0[3]); w.z = cvt_pk_bf16(v1[0], v1[1]); w.w = cvt_pk_bf16(v1[2], v1[3]); return w; }
__device__ __forceinline__ void unpack8(const u32x4 w, float (&e)[8]) { e[0] = bflo(w.x); e[1] = bfhi(w.x); e[2] = bflo(w.y); e[3] = bfhi(w.y); e[4] = bflo(w.z); e[5] = bfhi(w.z); e[6] = bflo(w.w); e[7] = bfhi(w.w); }
__device__ __forceinline__ float quad_reduce(float s) { s += __shfl_xor(s, 16); s += __shfl_xor(s, 32); return s; }

__device__ __forceinline__ int p16(int x) { return (x & 3) + 4 * ((x >> 3) & 1) + 8 * ((x >> 2) & 1); }

constexpr int SPARE_OFF = 131072, BL_OFF = SPARE_OFF + 8192, XST_OFF = 147440;
__device__ __forceinline__ void fill_rs_table(LAS unsigned char* lds, const float* ssq, const pg8::StaticOrder& S) {
    int tid_ = threadIdx.x; asm volatile("" : "+v"(tid_));
    LAS float* rsl = (LAS float*)(lds + SPARE_OFF);
#pragma unroll
    for (int k = 0; k < 6; ++k) {
        const int gi = tid_ + 512 * k, i = gi >> 8, row = gi & 255; pg8::Unit u; const bool ok = S.next(i, u); const int pm = ok ? u.pm : 0;
        const float rs = rstd16(ssq + (size_t)(pm * BM + row) * 16, 1.0f / 1024.0f);
        if (ok) rsl[gi] = rs;
    }
}
__device__ __forceinline__ void fill_gate_bias(LAS unsigned char* lds, const float* bgate, const pg8::StaticOrder& S) {
    int tid_ = threadIdx.x; asm volatile("" : "+v"(tid_));
    LAS float* bl = (LAS float*)(lds + BL_OFF);
#pragma unroll
    for (int k = 0; k < 4; ++k) {
        const int gi = tid_ + 512 * k, i = gi >> 8, c = gi & 255; pg8::Unit u; const bool ok = S.next(i, u); const int pn = ok ? u.pn : 0;
        const float v = bgate[(pn >> 2) * 1024 + (pn & 3) * 256 + c];
        if (ok) bl[gi] = v;
    }
}
struct EpiInA {
    static constexpr bool PERM = true, AFTER_DRAIN = false, SEG = false;
    static constexpr int TABLES = 1;
    const float* ssq; const LAS float* rsl; bf16_t* projb; bf16_t* cq; bf16_t* ckv; float* ssqq; float* ssqkv;
    const float* trc; const float* trs; const float* tmc; const float* tms; bf16_t* rvt; bf16_t* rkt; bf16_t* rq;
    template <int T> __device__ __forceinline__ void run(const f32x4 (&acc)[2][2][4][2], const Unit& u, int wr, int wc, int fr, int fq, int colbase, float sc, bf16_t* proj, const int LDP) const {
        const int lc0 = wc * 32 + 8 * fq;
        int rl0 = wr * 64 + fr; asm volatile("" : "+v"(rl0));
        const int rowbase = u.pm * BM + rl0; const LAS float* rsu = rsl + u.idx * 256 + rl0;
        int fqo = fq; asm volatile("" : "+v"(fqo));
#pragma unroll
        for (int ai = 0; ai < 2; ++ai)
#pragma unroll
            for (int m = 0; m < 4; ++m) {
                const int row = rowbase + ai * HALF + m * 16;
                const float rs = rsu[ai * HALF + m * 16] * sc;
                f32x4 v[2][2];
#pragma unroll
                for (int bj = 0; bj < 2; ++bj)
#pragma unroll
                    for (int n = 0; n < 2; ++n) v[bj][n] = acc[ai][bj][m][n] * rs;
                if constexpr (T == 8) {
                    const int bb = row >> 11, t = row & (SEQ - 1), tpos = (t & ~15) + p16(t & 15);
#pragma unroll
                    for (int bj = 0; bj < 2; ++bj) { const int vi = colbase + bj * HALF + lc0;
                        bf16_t* dst = rvt + ((size_t)bb * 512 + vi) * SEQ + tpos;
#pragma unroll
                        for (int j = 0; j < 4; ++j) { dst[(size_t)j * SEQ] = (bf16_t)f2bf(v[bj][0][j]); dst[(size_t)(4 + j) * SEQ] = (bf16_t)f2bf(v[bj][1][j]); } }
                } else if constexpr (T == 0 || T == 1 || T == 2) {
                    bf16_t* dst = proj + (size_t)row * LDP + colbase + lc0;
#pragma unroll
                    for (int bj = 0; bj < 2; ++bj) {
                        f32x4 a = v[bj][0], b = v[bj][1];
                        if constexpr (T == 1) { a = silu4(a); b = silu4(b); }
                        if constexpr (T == 2) { a = gelu4(a); b = gelu4(b); }
                        *(u32x4*)(dst + bj * HALF) = pack8(a, b);
                    }
                } else if constexpr (T == 3) {
                    bf16_t* dst = proj + (size_t)row * LDP + colbase + (lc0 >> 1);
#pragma unroll
                    for (int bj = 0; bj < 2; ++bj) { const f32x4 o = v[bj][0] * v[bj][1]; u32x2 w; w.x = cvt_pk_bf16(o[0], o[1]); w.y = cvt_pk_bf16(o[2], o[3]); *(u32x2*)(dst + bj * 64) = w; }
                } else if constexpr (T == 4 || T == 9) {
                    const int q = (wc & 1) * 4 + fqo;
                    const f32x4 c = *(const f32x4*)(trc + (size_t)row * 32 + 4 * q), s = *(const f32x4*)(trs + (size_t)row * 32 + 4 * q);
                    bf16_t* dst = proj + (size_t)row * LDP + colbase + lc0;
#pragma unroll
                    for (int bj = 0; bj < 2; ++bj) { const f32x4 x1 = v[bj][0], x2 = v[bj][1]; const f32x4 o1 = x1 * c - x2 * s, o2 = x1 * s + x2 * c; *(u32x4*)(dst + bj * HALF) = pack8(o1, o2);
                        if constexpr (T == 9) {
                            const int bb = row >> 11, t = row & (SEQ - 1), tpos = (t & ~15) + p16(t & 15), hd = bj * 2 + (wc >> 1);
                            const float dec = fast_exp2((float)(127 - (t & 127)) * __log2f(1.0f - exp2f(-(float)(5 + hd))));
                            bf16_t* kd = rkt + ((size_t)bb * 256 + bj * HALF + lc0) * SEQ + tpos;
#pragma unroll
                            for (int j = 0; j < 4; ++j) { kd[(size_t)j * SEQ] = (bf16_t)f2bf(o1[j] * dec); kd[(size_t)(4 + j) * SEQ] = (bf16_t)f2bf(o2[j] * dec); } } }
                } else if constexpr (T == 5) {
                    bf16_t* dst = cq + (size_t)row * 512 + lc0;
                    float s = 0.f;
#pragma unroll
                    for (int bj = 0; bj < 2; ++bj) { *(u32x4*)(dst + bj * HALF) = pack8(v[bj][0], v[bj][1]); s += hsq4(v[bj][0]) + hsq4(v[bj][1]); }
                    s = quad_reduce(s);
                    if (fq == 0) ssqq[(size_t)row * 8 + wc] = s;
                } else if constexpr (T == 6) {
                    bf16_t* dst = cq + (size_t)row * 512 + 256 + lc0;
                    *(u32x4*)dst = pack8(v[0][0], v[0][1]);
                    float s = quad_reduce(hsq4(v[0][0]) + hsq4(v[0][1]));
                    if (fq == 0) ssqq[(size_t)row * 8 + 4 + wc] = s;
                    if (wc == 0) {
                        const f32x4 c = *(const f32x4*)(tmc + (size_t)row * 16 + 4 * fqo), sn = *(const f32x4*)(tms + (size_t)row * 16 + 4 * fqo);
                        const f32x4 x1 = v[1][0], x2 = v[1][1];
                        *(u32x4*)(dst + HALF) = pack8(x1 * c - x2 * sn, x1 * sn + x2 * c);
                    } else { *(u32x4*)(dst + HALF) = (u32x4){0u, 0u, 0u, 0u}; }
                } else {
                    bf16_t* dst = ckv + (size_t)row * 256 + lc0;
                    float s = 0.f;
#pragma unroll
                    for (int bj = 0; bj < 2; ++bj) { *(u32x4*)(dst + bj * HALF) = pack8(v[bj][0], v[bj][1]); s += hsq4(v[bj][0]) + hsq4(v[bj][1]); }
                    s = quad_reduce(s);
                    if (fq == 0) ssqkv[(size_t)row * 4 + wc] = s;
                }
                asm volatile("" ::: "memory");
            }
    }
    __device__ __forceinline__ void operator()(const f32x4 (&acc)[2][2][4][2], const Unit& u, int wr, int wc, int fr, int fq) const {
        const int pn = u.pn;
        if (pn < 2) run<0>(acc, u, wr, wc, fr, fq, PC_AB + 256 * pn, 1.f, projb, ::LDP);
        else if (pn < 6) run<3>(acc, u, wr, wc, fr, fq, PC_CX + 128 * (pn - 2), 1.f, projb, ::LDP);
        else if (pn == 6) run<4>(acc, u, wr, wc, fr, fq, 0, 1.f, rq, 1024);
        else if (pn == 7) run<9>(acc, u, wr, wc, fr, fq, 256, 0.125f, rq, 1024);
        else if (pn < 10) run<8>(acc, u, wr, wc, fr, fq, 256 * (pn - 8), 1.f, projb, ::LDP);
        else if (pn < 12) run<1>(acc, u, wr, wc, fr, fq, 512 + 256 * (pn - 10), 1.f, rq, 1024);
        else if (pn < 16) run<2>(acc, u, wr, wc, fr, fq, PC_SU + 256 * (pn - 12), 1.f, projb, ::LDP);
        else if (pn == 16) run<5>(acc, u, wr, wc, fr, fq, 0, 1.f, projb, ::LDP);
        else if (pn == 17) run<6>(acc, u, wr, wc, fr, fq, 0, 1.f, projb, ::LDP);
        else run<7>(acc, u, wr, wc, fr, fq, 0, 1.f, projb, ::LDP);
    }
};

struct EpiGate {
    static constexpr bool PERM = true, AFTER_DRAIN = false, SEG = false;
    static constexpr int TABLES = 2;
    const float* ssq; const float* bgate; const LAS float* rsl; const LAS float* bl; bf16_t* G;
    __device__ __forceinline__ void operator()(const f32x4 (&acc)[2][2][4][2], const Unit& u, int wr, int wc, int fr, int fq) const {
        const int lc0 = wc * 32 + 8 * fq, br = u.pn >> 2, cb = (u.pn & 3) * 256 + lc0;
        int rl0 = wr * 64 + fr; asm volatile("" : "+v"(rl0));
        const int rowbase = u.pm * BM + rl0; const LAS float* rsu = rsl + u.idx * 256 + rl0;
        f32x4 bv[2][2];
#pragma unroll
        for (int bj = 0; bj < 2; ++bj)
#pragma unroll
            for (int n = 0; n < 2; ++n) bv[bj][n] = *(const LAS f32x4*)(bl + u.idx * 256 + lc0 + bj * HALF + 4 * n);
#pragma unroll
        for (int ai = 0; ai < 2; ++ai)
#pragma unroll
            for (int m = 0; m < 4; ++m) {
                const int row = rowbase + ai * HALF + m * 16;
                const float rs = rsu[ai * HALF + m * 16];
                bf16_t* dst = G + ((size_t)br * MH + row) * 1024 + cb;
#pragma unroll
                for (int bj = 0; bj < 2; ++bj) {
                    f32x4 a = acc[ai][bj][m][0] * rs + bv[bj][0], b = acc[ai][bj][m][1] * rs + bv[bj][1];
                    a = sigmoid4(a); b = sigmoid4(b);
#pragma unroll
                    for (int j = 0; j < 4; ++j) { a[j] = fmaxf(a[j], 1e-20f); b[j] = fmaxf(b[j], 1e-20f); }
                    *(u32x4*)(dst + bj * HALF) = pack8(a, b);
                }
            }
    }
};

struct EpiUpQ {
    static constexpr int TABLES = 0;
    static constexpr bool PERM = true, AFTER_DRAIN = false, SEG = false;
    const float* ssqq; const float* tmc; const float* tms; bf16_t* Q;
    __device__ __forceinline__ void operator()(const f32x4 (&acc)[2][2][4][2], const Unit& u, int wr, int wc, int fr, int fq) const {
        const int lc0 = wc * 32 + 8 * fq;
        int rowbase = u.pm * BM + wr * 64 + fr; asm volatile("" : "+v"(rowbase));
        bool isr[2]; int idx[2];
#pragma unroll
        for (int bj = 0; bj < 2; ++bj) { const int c8 = 256 * u.pn + bj * HALF + lc0, r96 = c8 % 96; isr[bj] = r96 >= 64; idx[bj] = isr[bj] ? ((r96 - 64) >> 3) * 4 : 0; }
#pragma unroll
        for (int ai = 0; ai < 2; ++ai)
#pragma unroll
            for (int m = 0; m < 4; ++m) {
                const int row = rowbase + ai * HALF + m * 16;
                const f32x4 s0 = *(const f32x4*)(ssqq + (size_t)row * 8), s1 = *(const f32x4*)(ssqq + (size_t)row * 8 + 4);
                const float rs = __builtin_amdgcn_rsqf((hsum4(s0) + hsum4(s1)) * (1.0f / 384.0f) + EPS) * QSCALE;
                bf16_t* dst = Q + (size_t)row * 768 + 256 * u.pn + lc0;
#pragma unroll
                for (int bj = 0; bj < 2; ++bj) {
                    const f32x4 x1 = acc[ai][bj][m][0] * rs, x2 = acc[ai][bj][m][1] * rs;
                    const f32x4 c = *(const f32x4*)(tmc + (size_t)row * 16 + idx[bj]), s = *(const f32x4*)(tms + (size_t)row * 16 + idx[bj]);
                    f32x4 o1 = x1 * c - x2 * s, o2 = x1 * s + x2 * c;
                    if (!isr[bj]) { o1 = x1; o2 = x2; }
                    *(u32x4*)(dst + bj * HALF) = pack8(o1, o2);
                }
                asm volatile("" ::: "memory");
            }
    }
};

struct EpiUpKV {
    static constexpr int TABLES = 0;
    static constexpr bool PERM = true, AFTER_DRAIN = false, SEG = false;
    const float* ssqkv; bf16_t* KV; bf16_t* VT;
    __device__ __forceinline__ void operator()(const f32x4 (&acc)[2][2][4][2], const Unit& u, int wr, int wc, int fr, int fq) const {
        const int lc0 = wc * 32 + 8 * fq;
        int rowbase = u.pm * BM + wr * 64 + fr; asm volatile("" : "+v"(rowbase));
#pragma unroll
        for (int ai = 0; ai < 2; ++ai)
#pragma unroll
            for (int m = 0; m < 4; ++m) {
                const int row = rowbase + ai * HALF + m * 16;
                const f32x4 s0 = *(const f32x4*)(ssqkv + (size_t)row * 4);
                const float rs = __builtin_amdgcn_rsqf(hsum4(s0) * (1.0f / 256.0f) + EPS);
                if (u.pn < 2) {
                    bf16_t* dst = KV + (size_t)row * 512 + 256 * u.pn + lc0;
#pragma unroll
                    for (int bj = 0; bj < 2; ++bj) *(u32x4*)(dst + bj * HALF) = pack8(acc[ai][bj][m][0] * rs, acc[ai][bj][m][1] * rs);
                } else {
                    const int bb = row >> 11, t = row & (SEQ - 1), tpos = (t & ~15) + p16(t & 15);
#pragma unroll
                    for (int bj = 0; bj < 2; ++bj) { const int vi = 256 * (u.pn - 2) + bj * HALF + lc0;
                        bf16_t* dst = VT + ((size_t)bb * 512 + vi) * SEQ + tpos;
#pragma unroll
                        for (int j = 0; j < 4; ++j) { dst[(size_t)j * SEQ] = (bf16_t)f2bf(acc[ai][bj][m][0][j] * rs); dst[(size_t)(4 + j) * SEQ] = (bf16_t)f2bf(acc[ai][bj][m][1][j] * rs); } }
                }
                asm volatile("" ::: "memory");
            }
    }
};

struct EpiMerged {
    static constexpr int TABLES = 0;
    static constexpr bool PERM = true, AFTER_DRAIN = false, SEG = true;
    const bf16_t* G; bf16_t* out;
    __device__ __forceinline__ void rescale(f32x4 (&acc)[2][2][4][2], const Unit& u, int seg, int wr, int wc, int fr, int fq) const {
        const int lc0 = wc * 32 + 8 * fq;
        int rowbase = u.pm * BM + wr * 64 + fr; asm volatile("" : "+v"(rowbase));
#pragma unroll
        for (int ai = 0; ai < 2; ++ai)
#pragma unroll
            for (int m = 0; m < 4; ++m) {
                const int row = rowbase + ai * HALF + m * 16;
                const bf16_t* g0 = G + ((size_t)(seg - 1) * MH + row) * 1024 + 256 * u.pn + lc0;
                const bf16_t* g1 = g0 + (size_t)MH * 1024;
#pragma unroll
                for (int bj = 0; bj < 2; ++bj) {
                    float a[8], b[8]; unpack8(*(const u32x4*)(g0 + bj * HALF), a); unpack8(*(const u32x4*)(g1 + bj * HALF), b);
#pragma unroll
                    for (int j = 0; j < 4; ++j) { acc[ai][bj][m][0][j] *= a[j] * fast_rcp(b[j]); acc[ai][bj][m][1][j] *= a[4 + j] * fast_rcp(b[4 + j]); }
                }
            }
    }
    __device__ __forceinline__ void operator()(const f32x4 (&acc)[2][2][4][2], const Unit& u, int wr, int wc, int fr, int fq) const {
        const int lc0 = wc * 32 + 8 * fq;
        int rowbase = u.pm * BM + wr * 64 + fr; asm volatile("" : "+v"(rowbase));
#pragma unroll
        for (int ai = 0; ai < 2; ++ai)
#pragma unroll
            for (int m = 0; m < 4; ++m) {
                const int row = rowbase + ai * HALF + m * 16;
                const bf16_t* g3 = G + ((size_t)3 * MH + row) * 1024 + 256 * u.pn + lc0;
                bf16_t* dst = out + (size_t)row * 1024 + 256 * u.pn + lc0;
#pragma unroll
                for (int bj = 0; bj < 2; ++bj) {
                    float a[8]; unpack8(*(const u32x4*)(g3 + bj * HALF), a);
                    f32x4 o0 = acc[ai][bj][m][0], o1 = acc[ai][bj][m][1];
#pragma unroll
                    for (int j = 0; j < 4; ++j) { o0[j] *= a[j]; o1[j] *= a[4 + j]; }
                    *(u32x4*)(dst + bj * HALF) = pack8(o0, o1);
                }
            }
    }
};

template <bool F32IN, bool F32OUT> struct EpiRes {
    static constexpr int TABLES = 0;
    static constexpr bool PERM = true, AFTER_DRAIN = false, SEG = false;
    const float* xres; float* xout; bf16_t* xb; float* ssq;
    __device__ __forceinline__ void operator()(const f32x4 (&acc)[2][2][4][2], const Unit& u, int wr, int wc, int fr, int fq) const {
        const int lc0 = wc * 32 + 8 * fq;
        int rowbase = u.pm * BM + wr * 64 + fr; asm volatile("" : "+v"(rowbase));
#pragma unroll
        for (int ai = 0; ai < 2; ++ai)
#pragma unroll
            for (int m = 0; m < 4; ++m) {
                const int row = rowbase + ai * HALF + m * 16;
                const size_t off = (size_t)row * 1024 + 256 * u.pn + lc0;
                float s = 0.f;
#pragma unroll
                for (int bj = 0; bj < 2; ++bj) {
                    f32x4 r0, r1;
                    if constexpr (F32IN) { r0 = *(const f32x4*)(xres + off + bj * HALF); r1 = *(const f32x4*)(xres + off + bj * HALF + 4); }
                    else { float e[8]; unpack8(*(const u32x4*)(xb + off + bj * HALF), e); r0 = (f32x4){e[0], e[1], e[2], e[3]}; r1 = (f32x4){e[4], e[5], e[6], e[7]}; }
                    const f32x4 o0 = r0 + acc[ai][bj][m][0], o1 = r1 + acc[ai][bj][m][1];
                    if constexpr (F32OUT) { *(f32x4*)(xout + off + bj * HALF) = o0; *(f32x4*)(xout + off + bj * HALF + 4) = o1; }
                    else *(u32x4*)(xb + off + bj * HALF) = pack8(o0, o1);
                    s += hsq4(o0) + hsq4(o1);
                }
                s = quad_reduce(s);
                if (fq == 0) ssq[(size_t)row * 16 + u.pn * 4 + wc] = s;
                asm volatile("" ::: "memory");
            }
    }
};

struct EpiFfnIn {
    static constexpr bool PERM = true, AFTER_DRAIN = false, SEG = false;
    static constexpr int TABLES = 1;
    const float* ssq; const LAS float* rsl; bf16_t* act;
    __device__ __forceinline__ void operator()(const f32x4 (&acc)[2][2][4][2], const Unit& u, int wr, int wc, int fr, int fq) const {
        const int lc0 = wc * 32 + 8 * fq;
        int rl0 = wr * 64 + fr; asm volatile("" : "+v"(rl0));
        const int rowbase = u.pm * BM + rl0; const LAS float* rsu = rsl + u.idx * 256 + rl0;
#pragma unroll
        for (int ai = 0; ai < 2; ++ai)
#pragma unroll
            for (int m = 0; m < 4; ++m) {
                const int row = rowbase + ai * HALF + m * 16;
                const float rs = rsu[ai * HALF + m * 16];
                bf16_t* dst = act + (size_t)row * DFF + 128 * u.pn + (lc0 >> 1);
#pragma unroll
                for (int bj = 0; bj < 2; ++bj) {
                    const f32x4 g = acc[ai][bj][m][0] * rs, uu = acc[ai][bj][m][1] * rs; const f32x4 o = silu4(g) * uu;
                    u32x2 w; w.x = cvt_pk_bf16(o[0], o[1]); w.y = cvt_pk_bf16(o[2], o[3]); *(u32x2*)(dst + bj * 64) = w;
                }
            }
    }
};

template <class Epi> __device__ __forceinline__ void run_gemm(LAS unsigned char* lds, const bf16_t* A, int lda, const bf16_t* Bt, int ldb, int K, int N, const Epi& E, int M = MH) {
    asm volatile("" : "+s"(lda), "+s"(ldb), "+s"(K), "+s"(N), "+s"(M));
    pg8::Gemm g{A, Bt, lda, ldb, K}; pg8::StaticOrder S; S.init(M, N, (int)gridDim.x, (int)blockIdx.x);
    if constexpr (Epi::TABLES >= 1) { fill_rs_table(lds, E.ssq, S); if constexpr (Epi::TABLES == 2) fill_gate_bias(lds, E.bgate, S); __syncthreads(); }
    pg8::gemm_phase<Epi, pg8::StaticOrder, true, true>(lds, g, S, E);
}

enum { MAP_NAT = 0, MAP_INA = 1, MAP_GATE = 2, MAP_UQ = 3, MAP_UKV = 4, MAP_FI = 5 };
__device__ __forceinline__ int pair8(int p, int half) { const int q = p >> 3, j = p & 7; return (j < 4) ? (4 * q + j) : (half + 4 * q + (j - 4)); }
__device__ __forceinline__ int map_col(int id, int n) {
    switch (id) {
    case MAP_INA:
        if (n < 512) return n;
        if (n < 1536) { const int c = n - 512, q = c >> 3, j = c & 7; return (j < 4) ? (512 + 4 * q + j) : (1024 + 4 * q + (j - 4)); }
        if (n < 2048) { const int c = n - 1536, base = (c >> 8) ? 1792 : 1536, cc = c & 255, h = cc >> 6; return base + 64 * h + pair8(cc & 63, 32); }
        if (n < 4096) return n;
        if (n < 4608) { const int c = n - 4096; if (c < 384) return 4096 + c; if (c < 416) return 4736 + pair8(c - 384, 16); return -1; }
        return 4480 + (n - 4608);
    case MAP_GATE: return 4768 + n;
    case MAP_UQ: { const int h = n / 96, c = n % 96; return (c < 64) ? (96 * h + c) : (96 * h + 64 + pair8(c - 64, 16)); }
    case MAP_UKV: { const int h = (n & 511) >> 6, d = n & 63; return 128 * h + d + ((n >= 512) ? 64 : 0); }
    case MAP_FI: { const int q = n >> 3, j = n & 7; return (j < 4) ? (4 * q + j) : (DFF + 4 * q + (j - 4)); }
    default: return n;
    }
}
__device__ __forceinline__ void transpose_item(const float* W, int K, int Nsrc, const float* ksc, bf16_t* WT, int mapid, int nblk, LAS float* scr, int item, int lane) {
    const int kb = item / nblk, nb = item % nblk, k0 = 64 * kb, n0 = 32 * nb;
    const int sc = map_col(mapid, n0 + (lane & 31));
    float tv[32];
#pragma unroll
    for (int i = 0; i < 32; ++i) { const int kk = 2 * i + (lane >> 5); tv[i] = (sc >= 0) ? W[(size_t)(k0 + kk) * Nsrc + sc] : 0.f; }
#pragma unroll
    for (int i = 0; i < 32; ++i) { const int kk = 2 * i + (lane >> 5); float v = tv[i]; if (ksc) v *= ksc[k0 + kk]; scr[kk * 33 + (lane & 31)] = v; }
    asm volatile("s_waitcnt lgkmcnt(0)" ::: "memory");
    const int c = lane & 7;
#pragma unroll
    for (int j = 0; j < 4; ++j) { const int n = (lane >> 3) + 8 * j; const LAS float* s = scr + (8 * c) * 33 + n;
        u32x4 o; o.x = cvt_pk_bf16(s[0 * 33], s[1 * 33]); o.y = cvt_pk_bf16(s[2 * 33], s[3 * 33]); o.z = cvt_pk_bf16(s[4 * 33], s[5 * 33]); o.w = cvt_pk_bf16(s[6 * 33], s[7 * 33]);
        *(u32x4*)(WT + (size_t)(n0 + n) * K + k0 + 8 * c) = o; }
    asm volatile("s_waitcnt lgkmcnt(0)" ::: "memory");
}

constexpr size_t WO_INA = 0, WO_GATE = WO_INA + (size_t)4864 * 1024, WO_UQ = WO_GATE + (size_t)4096 * 1024, WO_UKV = WO_UQ + (size_t)768 * 384, WO_BR = WO_UKV + (size_t)1024 * 256,
                 WO_OUT = WO_BR + (size_t)1024 * 2048, WO_FI = WO_OUT + (size_t)1024 * 1024, WO_FO = WO_FI + (size_t)5632 * 1024, WL_ELEMS = WO_FO + (size_t)1024 * 2816;
constexpr size_t OFF_W = 0, OFF_XB = OFF_W + 2 * WL_ELEMS * 2, OFF_SSQ = OFF_XB + (size_t)MTOT * 1024 * 2, OFF_TAB = OFF_SSQ + (size_t)MTOT * 16 * 4, OFF_PG = OFF_TAB + (size_t)MTOT * 96 * 4,
                 OFF_CQ = OFF_PG + (size_t)4 * MH * 1024 * 2, OFF_CKV = OFF_CQ + (size_t)MH * 512 * 2, OFF_SQQ = OFF_CKV + (size_t)MH * 256 * 2, OFF_SQKV = OFF_SQQ + (size_t)MH * 8 * 4,
                 OFF_Q = OFF_SQKV + (size_t)MH * 4 * 4, OFF_KV = OFF_Q + (size_t)MH * 768 * 2, OFF_Y = OFF_KV + (size_t)MH * 1024 * 2, OFF_RVT = OFF_Y + (size_t)MH * 2048 * 2, OFF_BAR = OFF_RVT + (size_t)MH * 512 * 2, OFF_RKT = OFF_BAR + 16384, OFF_KVT = OFF_RKT + (size_t)MH * 256 * 2, OFF_RQKG = OFF_KVT + (size_t)512 * 128 * 64 * 4, OFF_END = OFF_RQKG + (size_t)MH * 1024 * 2;
static_assert(OFF_XB % 256 == 0 && OFF_END <= (size_t)536870912 && OFF_PG + (size_t)MTOT * DFF * 2 <= OFF_KV, "workspace map");

struct Args { const float* in[20]; float* out; unsigned char* ws; };

__device__ __forceinline__ void p0_prep(const Args& a, LAS unsigned char* lds) {
    int tid_ = threadIdx.x; asm volatile("" : "+v"(tid_)); const int tid = tid_, lane = tid & 63, wave = __builtin_amdgcn_readfirstlane(tid >> 6);
    const int gw = blockIdx.x * 8 + wave, NGW = gridDim.x * 8;
    LAS float* scr = (LAS float*)(lds + wave * 16384);
    bf16_t* Wb = (bf16_t*)(a.ws + OFF_W);
    constexpr int I_INA = 16 * 152, I_GATE = 16 * 128, I_UQ = 6 * 24, I_UKV = 4 * 32, I_BR = 32 * 32, I_OUT = 16 * 32, I_FI = 16 * 176, I_FO = 44 * 32;
    constexpr int I_L = I_INA + I_GATE + I_UQ + I_UKV + I_BR + I_OUT + I_FI + I_FO;
    for (int it = gw; it < 2 * I_L; it += NGW) {
        const int l = it / I_L; int r = it % I_L; bf16_t* WL = Wb + (size_t)l * WL_ELEMS;
        const float* w_in = a.in[3] + (size_t)l * 1024 * NIN;
        if (r < I_INA) { transpose_item(w_in, 1024, NIN, a.in[2] + l * 1024, WL + WO_INA, MAP_INA, 152, scr, r, lane); continue; } r -= I_INA;
        if (r < I_GATE) { transpose_item(w_in, 1024, NIN, a.in[2] + l * 1024, WL + WO_GATE, MAP_GATE, 128, scr, r, lane); continue; } r -= I_GATE;
        if (r < I_UQ) { transpose_item(a.in[11] + (size_t)l * 384 * 768, 384, 768, a.in[10] + l * 384, WL + WO_UQ, MAP_UQ, 24, scr, r, lane); continue; } r -= I_UQ;
        if (r < I_UKV) { transpose_item(a.in[13] + (size_t)l * 256 * 1024, 256, 1024, a.in[12] + l * 256, WL + WO_UKV, MAP_UKV, 32, scr, r, lane); continue; } r -= I_UKV;
        if (r < I_BR) { transpose_item(a.in[14] + (size_t)l * 2048 * 1024, 2048, 1024, nullptr, WL + WO_BR, MAP_NAT, 32, scr, r, lane); continue; } r -= I_BR;
        if (r < I_OUT) { transpose_item(a.in[15] + (size_t)l * 1024 * 1024, 1024, 1024, nullptr, WL + WO_OUT, MAP_NAT, 32, scr, r, lane); continue; } r -= I_OUT;
        if (r < I_FI) { transpose_item(a.in[17] + (size_t)l * 1024 * 2 * DFF, 1024, 2 * DFF, a.in[16] + l * 1024, WL + WO_FI, MAP_FI, 176, scr, r, lane); continue; } r -= I_FI;
        transpose_item(a.in[18] + (size_t)l * DFF * 1024, DFF, 1024, nullptr, WL + WO_FO, MAP_NAT, 32, scr, r, lane);
    }
    bf16_t* XB = (bf16_t*)(a.ws + OFF_XB); float* SSQ = (float*)(a.ws + OFF_SSQ);
    for (int m0 = gw * 4; m0 < MTOT; m0 += NGW * 4) {
        f32x4 v[4][4];
#pragma unroll
        for (int rr = 0; rr < 4; ++rr) { const f32x4* xr = (const f32x4*)(a.in[0] + (size_t)(m0 + rr) * 1024) + lane;
#pragma unroll
            for (int j = 0; j < 4; ++j) v[rr][j] = xr[64 * j]; }
#pragma unroll
        for (int rr = 0; rr < 4; ++rr) { const int m = m0 + rr; float s = 0.f;
#pragma unroll
            for (int j = 0; j < 4; ++j) s += hsq4(v[rr][j]);
            s = wave_sum(s);
            u32x2* o8 = (u32x2*)(XB + (size_t)m * 1024) + lane;
#pragma unroll
            for (int j = 0; j < 4; ++j) { u32x2 w; w.x = cvt_pk_bf16(v[rr][j][0], v[rr][j][1]); w.y = cvt_pk_bf16(v[rr][j][2], v[rr][j][3]); o8[64 * j] = w; }
            if (lane < 16) SSQ[(size_t)m * 16 + lane] = (lane == 0) ? s : 0.f; }
    }
    float* tmc = (float*)(a.ws + OFF_TAB); float* tms = tmc + (size_t)MTOT * 16; float* trc = tms + (size_t)MTOT * 16; float* trs = trc + (size_t)MTOT * 32;
    const int* pos = (const int*)a.in[1];
    for (int i = blockIdx.x * 512 + tid; i < MTOT * 48; i += gridDim.x * 512) {
        const int t = i / 48, j = i % 48; const bool mla = j < 16; const int f = mla ? j : (j - 16);
        const float inv = exp2f(-(float)(2 * f) / (mla ? 32.0f : 64.0f) * 13.287712379549449f);
        const float ang = (float)pos[t] * inv;
        const double rev = (double)ang * 0.15915494309189535; const float fr = (float)(rev - floor(rev));
        const float c = __builtin_amdgcn_cosf(fr), s = __builtin_amdgcn_sinf(fr);
        if (mla) { tmc[(size_t)t * 16 + f] = c; tms[(size_t)t * 16 + f] = s; } else { trc[(size_t)t * 32 + f] = c; trs[(size_t)t * 32 + f] = s; }
    }
}

__device__ __forceinline__ void conv_phase(const bf16_t* proj, const float* cw, bf16_t* Y) {
    int tid_ = threadIdx.x; asm volatile("" : "+v"(tid_));
    const int stride = gridDim.x * 512;
    for (int idx0 = blockIdx.x * 512 + tid_; idx0 < MH * 64; idx0 += 4 * stride) {
        u32x4 ab[4], x0[4], x1[4], x2[4]; const u32x4 z = (u32x4){0u, 0u, 0u, 0u};
#pragma unroll
        for (int u = 0; u < 4; ++u) { const int idx = idx0 + u * stride; if (idx < MH * 64) { const int row = idx >> 6, c = (idx & 63) * 8, t = row & (SEQ - 1); const bf16_t* p = proj + (size_t)row * LDP;
            ab[u] = *(const u32x4*)(p + PC_AB + c); x0[u] = *(const u32x4*)(p + PC_CX + c);
            x1[u] = t >= 1 ? *(const u32x4*)(p - LDP + PC_CX + c) : z; x2[u] = t >= 2 ? *(const u32x4*)(p - 2 * LDP + PC_CX + c) : z; } }
#pragma unroll
        for (int u = 0; u < 4; ++u) { const int idx = idx0 + u * stride; if (idx < MH * 64) { const int row = idx >> 6, c = (idx & 63) * 8;
            float a[8], e0[8], e1[8], e2[8]; unpack8(ab[u], a); unpack8(x0[u], e0); unpack8(x1[u], e1); unpack8(x2[u], e2);
            f32x4 o0, o1;
#pragma unroll
            for (int j = 0; j < 8; ++j) { const float v = a[j] * (cw[c + j] * e2[j] + cw[512 + c + j] * e1[j] + cw[1024 + c + j] * e0[j]); if (j < 4) o0[j] = v; else o1[j - 4] = v; }
            *(u32x4*)(Y + (size_t)row * 2048 + c) = pack8(o0, o1); } }
    }
}

__device__ __forceinline__ void sg_phase(LAS unsigned char* lds, const bf16_t* proj, const float* lng, const float* lnb, const float* ws, const float* bs, bf16_t* Y) {
    int tid_ = threadIdx.x; asm volatile("" : "+v"(tid_)); const int tid = tid_, lane = tid & 63, wid = __builtin_amdgcn_readfirstlane(tid >> 6);
    LAS bf16_t* V = (LAS bf16_t*)lds;
    for (int unit = blockIdx.x; unit < (MH / 128) * 4; unit += gridDim.x) {
        const int ch = unit >> 2, g = unit & 3, row0 = ch * 128;
        for (int r = 0; r < 16; ++r) {
            const int j = wid * 16 + r; float x[8]; unpack8(*(const u32x4*)(proj + (size_t)(row0 + j) * LDP + PC_SV + lane * 8), x);
            float s = 0.f;
#pragma unroll
            for (int k = 0; k < 8; ++k) s += x[k];
            const float mean = wave_sum(s) * (1.0f / 512.0f); float q = 0.f;
#pragma unroll
            for (int k = 0; k < 8; ++k) { x[k] -= mean; q += x[k] * x[k]; }
            const float rstd = __builtin_amdgcn_rsqf(wave_sum(q) * (1.0f / 512.0f) + EPS);
            if ((lane >> 4) == g) {
                f32x4 o0, o1;
#pragma unroll
                for (int k = 0; k < 8; ++k) { const float v = x[k] * rstd * lng[lane * 8 + k] + lnb[lane * 8 + k]; if (k < 4) o0[k] = v; else o1[k - 4] = v; }
                *(LAS u32x4*)(V + j * 128 + (lane & 15) * 8) = pack8(o0, o1);
            }
        }
        __syncthreads();
        const int d = tid & 127, iq = tid >> 7;
        for (int ii = 0; ii < 32; ++ii) {
            const int i = iq + 4 * ii; const float* wrow = ws + (size_t)(g * 128 + i) * 128; float s = 0.f;
            for (int j = 0; j <= i; ++j) s += wrow[j] * bf2f(V[j * 128 + d]);
            s += bs[g * 128 + i];
            const float uu = bf2f(proj[(size_t)(row0 + i) * LDP + PC_SU + g * 128 + d]);
            Y[(size_t)(row0 + i) * 2048 + 1024 + g * 128 + d] = (bf16_t)f2bf(uu * s);
        }
        __syncthreads();
    }
}

__device__ __forceinline__ void ret_naive(LAS unsigned char* lds, const bf16_t* proj, bf16_t* Y) {
    int tid_ = threadIdx.x; asm volatile("" : "+v"(tid_)); const int tid = tid_, lane = tid & 63, wid = __builtin_amdgcn_readfirstlane(tid >> 6), tsub = wid >> 1, eh = wid & 1;
    LAS float* X = (LAS float*)lds;
    for (int item = blockIdx.x; item < 8 * 4 * 8; item += gridDim.x) {
        const int b = item >> 5, h = (item >> 3) & 3, tb = item & 7;
        const int t = tb * 256 + tsub * 64 + lane; const size_t row = (size_t)b * SEQ + t;
        const float lg2 = __log2f(1.0f - exp2f(-(float)(5 + h)));
        float q[64], acc[64];
#pragma unroll
        for (int i = 0; i < 8; ++i) { float e[8]; unpack8(*(const u32x4*)(proj + row * LDP + PC_RQ + h * 64 + i * 8), e);
#pragma unroll
            for (int k = 0; k < 8; ++k) q[i * 8 + k] = e[k]; }
#pragma unroll
        for (int e = 0; e < 64; ++e) acc[e] = 0.f;
        const int smax = tb * 256 + tsub * 64 + 63;
        for (int s = 0; s <= smax; ++s) {
            const bf16_t* kp = proj + ((size_t)b * SEQ + s) * LDP + PC_RK + h * 64; float dot = 0.f;
#pragma unroll
            for (int i = 0; i < 8; ++i) { float e[8]; unpack8(*(const u32x4*)(kp + i * 8), e);
#pragma unroll
                for (int k = 0; k < 8; ++k) dot += q[i * 8 + k] * e[k]; }
            const int n = t - s; const float w = (n >= 0) ? exp2f((float)n * lg2) * dot : 0.f;
            const bf16_t* vp = proj + ((size_t)b * SEQ + s) * LDP + PC_RV + h * 128 + eh * 64;
#pragma unroll
            for (int i = 0; i < 8; ++i) { float e[8]; unpack8(*(const u32x4*)(vp + i * 8), e);
#pragma unroll
                for (int k = 0; k < 8; ++k) acc[i * 8 + k] += w * e[k]; }
        }
        float s1 = 0.f;
#pragma unroll
        for (int e = 0; e < 64; ++e) s1 += acc[e];
        X[(tsub * 64 + lane) * 2 + eh] = s1; __syncthreads();
        const float mean = (X[(tsub * 64 + lane) * 2] + X[(tsub * 64 + lane) * 2 + 1]) * (1.0f / 128.0f); __syncthreads();
        float s2 = 0.f;
#pragma unroll
        for (int e = 0; e < 64; ++e) { acc[e] -= mean; s2 += acc[e] * acc[e]; }
        X[(tsub * 64 + lane) * 2 + eh] = s2; __syncthreads();
        const float rstd = __builtin_amdgcn_rsqf((X[(tsub * 64 + lane) * 2] + X[(tsub * 64 + lane) * 2 + 1]) * (1.0f / 128.0f) + EPS); __syncthreads();
        const bf16_t* gp = proj + row * LDP + PC_RG + h * 128 + eh * 64; bf16_t* yp = Y + row * 2048 + 512 + h * 128 + eh * 64;
#pragma unroll
        for (int i = 0; i < 8; ++i) { float g[8]; unpack8(*(const u32x4*)(gp + i * 8), g); f32x4 o0, o1;
#pragma unroll
            for (int k = 0; k < 4; ++k) { o0[k] = acc[i * 8 + k] * rstd * g[k]; o1[k] = acc[i * 8 + 4 + k] * rstd * g[4 + k]; }
            *(u32x4*)(yp + i * 8) = pack8(o0, o1); }
    }
}

__device__ __forceinline__ void attn_naive(const bf16_t* Q, const bf16_t* KV, const bf16_t* CQ, bf16_t* Y) {
    int tid_ = threadIdx.x; asm volatile("" : "+v"(tid_)); const int tid = tid_, lane = tid & 63, wid = __builtin_amdgcn_readfirstlane(tid >> 6), tsub = wid >> 1, eh = wid & 1;
    for (int item = blockIdx.x; item < 8 * 8 * 8; item += gridDim.x) {
        const int b = item >> 6, h = (item >> 3) & 7, tb = item & 7;
        const int t = tb * 256 + tsub * 64 + lane; const size_t row = (size_t)b * SEQ + t;
        float q[96], acc[32];
#pragma unroll
        for (int i = 0; i < 12; ++i) { float e[8]; unpack8(*(const u32x4*)(Q + row * 768 + h * 96 + i * 8), e);
#pragma unroll
            for (int k = 0; k < 8; ++k) q[i * 8 + k] = e[k]; }
#pragma unroll
        for (int e = 0; e < 32; ++e) acc[e] = 0.f;
        float mx = -1e30f, l = 0.f;
        const int smax = tb * 256 + tsub * 64 + 63;
        for (int s = 0; s <= smax; ++s) {
            const size_t kr = (size_t)b * SEQ + s;
            const bf16_t* kn = KV + kr * 1024 + h * 64; const bf16_t* kp = CQ + kr * 512 + 384; float sc = 0.f;
#pragma unroll
            for (int i = 0; i < 8; ++i) { float e[8]; unpack8(*(const u32x4*)(kn + i * 8), e);
#pragma unroll
                for (int k = 0; k < 8; ++k) sc += q[i * 8 + k] * e[k]; }
#pragma unroll
            for (int i = 0; i < 4; ++i) { float e[8]; unpack8(*(const u32x4*)(kp + i * 8), e);
#pragma unroll
                for (int k = 0; k < 8; ++k) sc += q[64 + i * 8 + k] * e[k]; }
            const bool ok = s <= t;
            const float mn = ok ? fmaxf(mx, sc) : mx, corr = exp2f(mx - mn), p = ok ? exp2f(sc - mn) : 0.f;
            l = l * corr + p; mx = mn;
            const bf16_t* vp = KV + kr * 1024 + 512 + h * 64 + eh * 32;
#pragma unroll
            for (int i = 0; i < 4; ++i) { float e[8]; unpack8(*(const u32x4*)(vp + i * 8), e);
#pragma unroll
                for (int k = 0; k < 8; ++k) acc[i * 8 + k] = acc[i * 8 + k] * corr + p * e[k]; }
        }
        const float il = 1.0f / l; bf16_t* yp = Y + row * 2048 + 1536 + h * 64 + eh * 32;
#pragma unroll
        for (int i = 0; i < 4; ++i) { f32x4 o0, o1;
#pragma unroll
            for (int k = 0; k < 4; ++k) { o0[k] = acc[i * 8 + k] * il; o1[k] = acc[i * 8 + 4 + k] * il; }
            *(u32x4*)(yp + i * 8) = pack8(o0, o1); }
    }
}


typedef float f32x16 __attribute__((ext_vector_type(16)));
template <int MODE> __device__ __forceinline__ void flash_item(LAS unsigned char* lds, int b, int hd, int qb, const bf16_t* Qp, const bf16_t* Kp, const bf16_t* Kpe, const bf16_t* VT, const bf16_t* Gp, bf16_t* Y) {
    constexpr int NKS = MODE == 0 ? 6 : 4, NES = MODE == 0 ? 2 : 4, KP = MODE == 0 ? 208 : 144, VP = 144;
    constexpr int KBYTES = 64 * KP, STAGE = KBYTES + NES * 32 * VP;
    int tid_ = threadIdx.x; asm volatile("" : "+v"(tid_));
    const int tid = tid_, lane = tid & 63, wid = __builtin_amdgcn_readfirstlane(tid >> 6), r = lane & 31, hh = lane >> 5;
    const int Q0 = qb * 256 + wid * 32, query = Q0 + r; const size_t qrow = (size_t)b * SEQ + query;
    bf16x8 qf[NKS];
#pragma unroll
    for (int ks = 0; ks < NKS; ++ks) qf[ks] = (MODE == 0) ? *(const bf16x8*)(Qp + qrow * 768 + hd * 96 + ks * 16 + hh * 8) : *(const bf16x8*)(Qp + qrow * LDP + PC_RQ + hd * 64 + ks * 16 + hh * 8);
    f32x16 o[NES];
#pragma unroll
    for (int e = 0; e < NES; ++e)
#pragma unroll
        for (int i = 0; i < 16; ++i) o[e][i] = 0.f;
    float mrun = -1e30f, lrun = 0.f;
    const float lg2 = (MODE == 1) ? __log2f(1.0f - exp2f(-(float)(5 + hd))) : 0.f;
    float cdec[16];
    if (MODE == 1) {
#pragma unroll
        for (int i = 0; i < 16; ++i) cdec[i] = exp2f(-(float)((i & 3) + 8 * (i >> 2) + 4 * hh) * lg2);
    }
    const int nt = 4 * qb + 4, my_last = Q0 >> 6;
    const bf16_t *g0, *g1, *g2; unsigned l0, l1, l2; size_t st0, st1, st2;
    if (MODE == 0) {
        g0 = Kp + ((size_t)b * SEQ + (tid >> 3)) * 512 + hd * 64 + (tid & 7) * 8; st0 = (size_t)64 * 512; l0 = (tid >> 3) * KP + (tid & 7) * 16;
        g1 = Kpe + ((size_t)b * SEQ + ((tid & 255) >> 2)) * 512 + 384 + (tid & 3) * 8; st1 = (size_t)64 * 512; l1 = ((tid & 255) >> 2) * KP + 128 + (tid & 3) * 16;
        g2 = VT + ((size_t)(b * 8 + hd) * 64 + (tid >> 3)) * SEQ + (tid & 7) * 8; st2 = 64; l2 = KBYTES + (tid >> 3) * VP + (tid & 7) * 16;
    } else {
        g0 = Kp + ((size_t)b * SEQ + (tid >> 3)) * LDP + PC_RK + hd * 64 + (tid & 7) * 8; st0 = (size_t)64 * LDP; l0 = (tid >> 3) * KP + (tid & 7) * 16;
        g1 = VT + ((size_t)(b * 4 + hd) * 128 + (tid >> 3)) * SEQ + (tid & 7) * 8; st1 = 64; l1 = KBYTES + (tid >> 3) * VP + (tid & 7) * 16;
        g2 = g1 + (size_t)64 * SEQ; st2 = 64; l2 = l1 + 64 * VP;
    }
    const bool has1 = (MODE == 1) || (tid < 256);
    u32x4 a0, a1 = (u32x4){0u, 0u, 0u, 0u}, a2, b0, b1 = (u32x4){0u, 0u, 0u, 0u}, b2;
#define FL_LOAD(x0, x1, x2, tt) do { x0 = *(const u32x4*)(g0 + (size_t)(tt) * st0); if (has1) x1 = *(const u32x4*)(g1 + (size_t)(tt) * st1); x2 = *(const u32x4*)(g2 + (size_t)(tt) * st2); } while (0)
#define FL_STORE(x0, x1, x2, tt) do { LAS unsigned char* nb_ = lds + ((tt) & 1) * STAGE; *(LAS u32x4*)(nb_ + l0) = x0; if (has1) *(LAS u32x4*)(nb_ + l1) = x1; *(LAS u32x4*)(nb_ + l2) = x2; } while (0)
    FL_LOAD(a0, a1, a2, 0); FL_STORE(a0, a1, a2, 0);
    b0 = a0; b2 = a2; if (nt > 1) FL_LOAD(b0, b1, b2, 1);
    __syncthreads();
    auto compute = [&](const int t) __attribute__((always_inline)) {
        LAS unsigned char* buf = lds + (t & 1) * STAGE;
        if (t <= my_last) {
            f32x16 s[2];
            {
                bf16x8 kf[2][NKS];
#pragma unroll
                for (int sub = 0; sub < 2; ++sub)
#pragma unroll
                    for (int ks = 0; ks < NKS; ++ks) kf[sub][ks] = *(const LAS bf16x8*)(buf + (32 * sub + r) * KP + ks * 32 + hh * 16);
#pragma unroll
                for (int sub = 0; sub < 2; ++sub)
#pragma unroll
                    for (int i = 0; i < 16; ++i) s[sub][i] = 0.f;
                __builtin_amdgcn_sched_barrier(0);
#pragma unroll
                for (int ks = 0; ks < NKS; ++ks)
#pragma unroll
                    for (int sub = 0; sub < 2; ++sub) s[sub] = __builtin_amdgcn_mfma_f32_32x32x16_bf16(kf[sub][ks], qf[ks], s[sub], 0, 0, 0);
            }
            const int kbase = 64 * t + 4 * hh;
            if (MODE == 0) {
                if (t == my_last) {
#pragma unroll
                    for (int sub = 0; sub < 2; ++sub)
#pragma unroll
                        for (int i = 0; i < 16; ++i) if (kbase + 32 * sub + (i & 3) + 8 * (i >> 2) > query) s[sub][i] = -1e30f;
                }
                float mx0 = fmaxf(fmaxf(s[0][0], s[0][1]), s[0][2]), mx1 = fmaxf(fmaxf(s[1][0], s[1][1]), s[1][2]);
#pragma unroll
                for (int i = 3; i < 15; i += 2) { mx0 = fmaxf(fmaxf(mx0, s[0][i]), s[0][i + 1]); mx1 = fmaxf(fmaxf(mx1, s[1][i]), s[1][i + 1]); }
                float mx = fmaxf(fmaxf(mx0, mx1), fmaxf(s[0][15], s[1][15]));
                mx = fmaxf(mx, __shfl_xor(mx, 32));
                if (__builtin_amdgcn_ballot_w64(mx > mrun + 6.0f) != 0ull) {
                    const float mn = fmaxf(mrun, mx), corr = fast_exp2(mrun - mn); mrun = mn; lrun *= corr;
#pragma unroll
                    for (int e = 0; e < NES; ++e)
#pragma unroll
                        for (int i = 0; i < 16; ++i) o[e][i] *= corr;
                }
                float ls0 = 0.f, ls1 = 0.f;
#pragma unroll
                for (int i = 0; i < 16; ++i) { s[0][i] = fast_exp2(s[0][i] - mrun); ls0 += s[0][i]; s[1][i] = fast_exp2(s[1][i] - mrun); ls1 += s[1][i]; }
                lrun += ls0 + ls1;
            } else {
#pragma unroll
                for (int sub = 0; sub < 2; ++sub) {
                    const float f = fast_exp2((float)(query - 64 * t - 32 * sub) * lg2);
#pragma unroll
                    for (int i = 0; i < 16; ++i) s[sub][i] *= f * cdec[i];
                }
                if (t == my_last) {
#pragma unroll
                    for (int sub = 0; sub < 2; ++sub)
#pragma unroll
                        for (int i = 0; i < 16; ++i) if (kbase + 32 * sub + (i & 3) + 8 * (i >> 2) > query) s[sub][i] = 0.f;
                }
            }
            bf16x8 pf[2][2];
#pragma unroll
            for (int sub = 0; sub < 2; ++sub)
#pragma unroll
                for (int s2 = 0; s2 < 2; ++s2) { u32x4 w; w.x = cvt_pk_bf16(s[sub][8 * s2 + 0], s[sub][8 * s2 + 1]); w.y = cvt_pk_bf16(s[sub][8 * s2 + 2], s[sub][8 * s2 + 3]);
                    w.z = cvt_pk_bf16(s[sub][8 * s2 + 4], s[sub][8 * s2 + 5]); w.w = cvt_pk_bf16(s[sub][8 * s2 + 6], s[sub][8 * s2 + 7]); pf[sub][s2] = __builtin_bit_cast(bf16x8, w); }
#pragma unroll
            for (int ep = 0; ep < NES; ep += 2) {
                bf16x8 vf[2][4];
#pragma unroll
                for (int e = 0; e < 2; ++e)
#pragma unroll
                    for (int kk = 0; kk < 4; ++kk) vf[e][kk] = *(const LAS bf16x8*)(buf + KBYTES + (32 * (ep + e) + r) * VP + kk * 32 + hh * 16);
                __builtin_amdgcn_sched_barrier(0);
#pragma unroll
                for (int kk = 0; kk < 4; ++kk)
#pragma unroll
                    for (int e = 0; e < 2; ++e) o[ep + e] = __builtin_amdgcn_mfma_f32_32x32x16_bf16(vf[e][kk], pf[kk >> 1][kk & 1], o[ep + e], 0, 0, 0);
            }
        }
    };
    for (int t = 0; t < nt; t += 2) {
        if (t + 2 < nt) FL_LOAD(a0, a1, a2, t + 2);
        compute(t);
        if (t + 1 < nt) FL_STORE(b0, b1, b2, t + 1);
        __syncthreads();
        if (t + 1 >= nt) break;
        if (t + 3 < nt) FL_LOAD(b0, b1, b2, t + 3);
        compute(t + 1);
        if (t + 2 < nt) FL_STORE(a0, a1, a2, t + 2);
        __syncthreads();
    }
#undef FL_LOAD
#undef FL_STORE
    if (MODE == 0) {
        const float inv = 1.0f / (lrun + __shfl_xor(lrun, 32));
        bf16_t* yp = Y + qrow * 2048 + 1536 + hd * 64 + 4 * hh;
#pragma unroll
        for (int e = 0; e < NES; ++e)
#pragma unroll
            for (int g = 0; g < 4; ++g) { u32x2 w; w.x = cvt_pk_bf16(o[e][4 * g] * inv, o[e][4 * g + 1] * inv); w.y = cvt_pk_bf16(o[e][4 * g + 2] * inv, o[e][4 * g + 3] * inv); *(u32x2*)(yp + 32 * e + 8 * g) = w; }
    } else {
        float s1 = 0.f;
#pragma unroll
        for (int e = 0; e < NES; ++e)
#pragma unroll
            for (int i = 0; i < 16; ++i) s1 += o[e][i];
        const float mean = (s1 + __shfl_xor(s1, 32)) * (1.0f / 128.0f); float s2 = 0.f;
#pragma unroll
        for (int e = 0; e < NES; ++e)
#pragma unroll
            for (int i = 0; i < 16; ++i) { o[e][i] -= mean; s2 += o[e][i] * o[e][i]; }
        const float rstd = __builtin_amdgcn_rsqf((s2 + __shfl_xor(s2, 32)) * (1.0f / 128.0f) + EPS);
        const bf16_t* gp = Gp + qrow * LDP + PC_RG + hd * 128 + 4 * hh; bf16_t* yp = Y + qrow * 2048 + 512 + hd * 128 + 4 * hh;
#pragma unroll
        for (int e = 0; e < NES; ++e)
#pragma unroll
            for (int g = 0; g < 4; ++g) { const u32x2 gw = *(const u32x2*)(gp + 32 * e + 8 * g);
                u32x2 w; w.x = cvt_pk_bf16(o[e][4 * g] * rstd * bflo(gw.x), o[e][4 * g + 1] * rstd * bfhi(gw.x)); w.y = cvt_pk_bf16(o[e][4 * g + 2] * rstd * bflo(gw.y), o[e][4 * g + 3] * rstd * bfhi(gw.y)); *(u32x2*)(yp + 32 * e + 8 * g) = w; }
    }
}
__device__ __forceinline__ void attn_phase(LAS unsigned char* lds, const bf16_t* Q, const bf16_t* KN, const bf16_t* CQ, const bf16_t* VT, bf16_t* Y) {
    const int vid0 = (gridDim.x % 8 == 0) ? (int)((blockIdx.x % 8) * (gridDim.x / 8) + blockIdx.x / 8) : (int)blockIdx.x;
    for (int pr = vid0; pr < 256; pr += gridDim.x) {
        const int bh = pr >> 2, p = pr & 3;
        flash_item<0>(lds, bh >> 3, bh & 7, 7 - p, Q, KN, CQ, VT, nullptr, Y);
        flash_item<0>(lds, bh >> 3, bh & 7, p, Q, KN, CQ, VT, nullptr, Y);
    }
}
__device__ __forceinline__ void ret_phase(LAS unsigned char* lds, const bf16_t* proj, const bf16_t* RVT, bf16_t* Y) {
    for (int it = blockIdx.x; it < 256; it += gridDim.x) { const int bh = it >> 3, qb = it & 7; flash_item<1>(lds, bh >> 2, bh & 3, qb, proj, proj, nullptr, RVT, proj, Y); }
}


__device__ __forceinline__ void sg_phase2(LAS unsigned char* lds, const bf16_t* proj, const float* lng, const float* lnb, const float* ws, const float* bs, bf16_t* Y) {
    int tid_ = threadIdx.x; asm volatile("" : "+v"(tid_));
    const int tid = tid_, lane = tid & 63, wid = __builtin_amdgcn_readfirstlane(tid >> 6), r = lane & 31, hh = lane >> 5;
    constexpr int PB = 272;
    LAS unsigned char* Wl = lds; LAS unsigned char* Vl = lds + 128 * PB; LAS float* St = (LAS float*)(lds + 2 * 128 * PB);
    int gcur = -1;
    for (int unit = blockIdx.x; unit < (MH / 128) * 4; unit += gridDim.x) {
        const int g = unit & 3, ch = unit >> 2, row0 = ch * 128;
        {
            const int rrow = wid * 16 + (lane >> 2), qq = lane & 3;
            const bf16_t* rp = proj + (size_t)(row0 + rrow) * LDP + PC_SV + qq * 8;
            u32x4 xr[16];
#pragma unroll
            for (int i = 0; i < 16; ++i) xr[i] = *(const u32x4*)(rp + i * 32);
            if (g != gcur) {
                gcur = g; const int i = tid >> 2, q = tid & 3; const float* wp = ws + (size_t)(g * 128 + i) * 128 + 32 * q;
#pragma unroll
                for (int c = 0; c < 4; ++c) { f32x4 a = *(const f32x4*)(wp + 8 * c), bq = *(const f32x4*)(wp + 8 * c + 4);
#pragma unroll
                    for (int k = 0; k < 4; ++k) { if (32 * q + 8 * c + k > i) a[k] = 0.f; if (32 * q + 8 * c + 4 + k > i) bq[k] = 0.f; }
                    *(LAS u32x4*)(Wl + i * PB + (32 * q + 8 * c) * 2) = pack8(a, bq); }
            }
            float sm = 0.f;
#pragma unroll
            for (int i = 0; i < 16; ++i) { float x[8]; unpack8(xr[i], x);
#pragma unroll
                for (int k = 0; k < 8; ++k) sm += x[k]; }
            sm += __shfl_xor(sm, 1); sm += __shfl_xor(sm, 2);
            const float mean = sm * (1.0f / 512.0f); float q2 = 0.f;
#pragma unroll
            for (int i = 0; i < 16; ++i) { float x[8]; unpack8(xr[i], x);
#pragma unroll
                for (int k = 0; k < 8; ++k) { const float d = x[k] - mean; q2 += d * d; } }
            q2 += __shfl_xor(q2, 1); q2 += __shfl_xor(q2, 2);
            if (qq == 0) { St[2 * rrow] = mean; St[2 * rrow + 1] = __builtin_amdgcn_rsqf(q2 * (1.0f / 512.0f) + EPS); }
        }
        __syncthreads();
        {
            const int d = tid & 127, jb = tid >> 7; const float gg = lng[g * 128 + d], bb = lnb[g * 128 + d];
            const bf16_t* xp = proj + (size_t)(row0 + 32 * jb) * LDP + PC_SV + g * 128 + d;
#pragma unroll
            for (int c = 0; c < 4; ++c) { f32x4 a, bq;
#pragma unroll
                for (int k = 0; k < 4; ++k) { const int j0 = 8 * c + k, j1 = 8 * c + 4 + k;
                    a[k] = (bf2f(xp[(size_t)j0 * LDP]) - St[2 * (32 * jb + j0)]) * St[2 * (32 * jb + j0) + 1] * gg + bb;
                    bq[k] = (bf2f(xp[(size_t)j1 * LDP]) - St[2 * (32 * jb + j1)]) * St[2 * (32 * jb + j1) + 1] * gg + bb; }
                *(LAS u32x4*)(Vl + d * PB + (32 * jb + 8 * c) * 2) = pack8(a, bq); }
        }
        __syncthreads();
        {
            const int ib = wid >> 1, db0 = 2 * (wid & 1);
            f32x16 acc[2];
#pragma unroll
            for (int e = 0; e < 2; ++e)
#pragma unroll
                for (int i = 0; i < 16; ++i) acc[e][i] = 0.f;
            unsigned short uraw[2][16]; float bsv[16];
#pragma unroll
            for (int i = 0; i < 16; ++i) { const int ii = 32 * ib + (i & 3) + 8 * (i >> 2) + 4 * hh; bsv[i] = bs[g * 128 + ii];
#pragma unroll
                for (int e = 0; e < 2; ++e) uraw[e][i] = proj[(size_t)(row0 + ii) * LDP + PC_SU + g * 128 + 32 * (db0 + e) + r]; }
            for (int ks = 0; ks < 2 * ib + 2; ++ks) {
                const bf16x8 af = *(const LAS bf16x8*)(Wl + (32 * ib + r) * PB + ks * 32 + hh * 16);
#pragma unroll
                for (int e = 0; e < 2; ++e) { const bf16x8 bf = *(const LAS bf16x8*)(Vl + (32 * (db0 + e) + r) * PB + ks * 32 + hh * 16); acc[e] = __builtin_amdgcn_mfma_f32_32x32x16_bf16(af, bf, acc[e], 0, 0, 0); }
            }
#pragma unroll
            for (int e = 0; e < 2; ++e)
#pragma unroll
                for (int i = 0; i < 16; ++i) { const int ii = 32 * ib + (i & 3) + 8 * (i >> 2) + 4 * hh, dd = g * 128 + 32 * (db0 + e) + r;
                    Y[(size_t)(row0 + ii) * 2048 + 1024 + dd] = (bf16_t)f2bf(bf2f(uraw[e][i]) * (acc[e][i] + bsv[i])); }
        }
        __syncthreads();
    }
}


__device__ __forceinline__ void ret_item2(LAS unsigned char* lds, int b, int hd, int qb16, const bf16_t* proj, const bf16_t* VT, bf16_t* Y) {
    constexpr int NKS = 4, NES = 4, KP = 144, VP = 272;
    constexpr int KBYTES = 128 * KP, STAGE = KBYTES + 128 * VP;
    int tid_ = threadIdx.x; asm volatile("" : "+v"(tid_));
    const int tid = tid_, lane = tid & 63, wid = __builtin_amdgcn_readfirstlane(tid >> 6), r = lane & 31, hh = lane >> 5, kh = wid >> 2;
    const int Q0 = qb16 * 128 + (wid & 3) * 32, query = Q0 + r; const size_t qrow = (size_t)b * SEQ + query;
    bf16x8 qf[NKS];
#pragma unroll
    for (int ks = 0; ks < NKS; ++ks) qf[ks] = *(const bf16x8*)(proj + qrow * LDP + PC_RQ + hd * 64 + ks * 16 + hh * 8);
    f32x16 o[NES];
#pragma unroll
    for (int e = 0; e < NES; ++e)
#pragma unroll
        for (int i = 0; i < 16; ++i) o[e][i] = 0.f;
    const float lg2 = __log2f(1.0f - exp2f(-(float)(5 + hd)));
    float cdec[16];
#pragma unroll
    for (int i = 0; i < 16; ++i) cdec[i] = exp2f(-(float)((i & 3) + 8 * (i >> 2) + 4 * hh) * lg2);
    const int nt = qb16 + 1, my_last = Q0 >> 6;
    const bf16_t* gk = proj + ((size_t)b * SEQ + (tid >> 3)) * LDP + PC_RK + hd * 64 + (tid & 7) * 8;
    const bf16_t* gv = VT + ((size_t)(b * 4 + hd) * 128 + (tid >> 4)) * SEQ + (tid & 15) * 8;
    const unsigned lk = (tid >> 3) * KP + (tid & 7) * 16, lv = KBYTES + (tid >> 4) * VP + (tid & 15) * 16;
    u32x4 ak[2], av[4], bk[2], bv[4];
#define RT_LOAD(xk, xv, tt) do { _Pragma("unroll") for (int i_ = 0; i_ < 2; ++i_) xk[i_] = *(const u32x4*)(gk + (size_t)(128 * (tt) + 64 * i_) * LDP); \
        _Pragma("unroll") for (int i_ = 0; i_ < 4; ++i_) xv[i_] = *(const u32x4*)(gv + (size_t)(32 * i_) * SEQ + 128 * (tt)); } while (0)
#define RT_STORE(xk, xv, tt) do { LAS unsigned char* nb_ = lds + ((tt) & 1) * STAGE; _Pragma("unroll") for (int i_ = 0; i_ < 2; ++i_) *(LAS u32x4*)(nb_ + lk + 64 * i_ * KP) = xk[i_]; \
        _Pragma("unroll") for (int i_ = 0; i_ < 4; ++i_) *(LAS u32x4*)(nb_ + lv + 32 * i_ * VP) = xv[i_]; } while (0)
    RT_LOAD(ak, av, 0); RT_STORE(ak, av, 0);
#pragma unroll
    for (int i = 0; i < 2; ++i) bk[i] = ak[i];
#pragma unroll
    for (int i = 0; i < 4; ++i) bv[i] = av[i];
    if (nt > 1) RT_LOAD(bk, bv, 1);
    __syncthreads();
    auto compute = [&](const int t) __attribute__((always_inline)) {
        LAS unsigned char* buf = lds + (t & 1) * STAGE;
        const int tile = 2 * t + kh;
        if (tile <= my_last) {
            f32x16 s[2];
            {
                bf16x8 kf[2][NKS];
#pragma unroll
                for (int sub = 0; sub < 2; ++sub)
#pragma unroll
                    for (int ks = 0; ks < NKS; ++ks) kf[sub][ks] = *(const LAS bf16x8*)(buf + (64 * kh + 32 * sub + r) * KP + ks * 32 + hh * 16);
#pragma unroll
                for (int sub = 0; sub < 2; ++sub)
#pragma unroll
                    for (int i = 0; i < 16; ++i) s[sub][i] = 0.f;
                __builtin_amdgcn_sched_barrier(0);
#pragma unroll
                for (int ks = 0; ks < NKS; ++ks)
#pragma unroll
                    for (int sub = 0; sub < 2; ++sub) s[sub] = __builtin_amdgcn_mfma_f32_32x32x16_bf16(kf[sub][ks], qf[ks], s[sub], 0, 0, 0);
            }
            const int kbase = 64 * tile + 4 * hh;
#pragma unroll
            for (int sub = 0; sub < 2; ++sub) {
                const float f = fast_exp2((float)(query - 64 * tile - 32 * sub) * lg2);
#pragma unroll
                for (int i = 0; i < 16; ++i) s[sub][i] *= f * cdec[i];
            }
            if (tile == my_last) {
#pragma unroll
                for (int sub = 0; sub < 2; ++sub)
#pragma unroll
                    for (int i = 0; i < 16; ++i) if (kbase + 32 * sub + (i & 3) + 8 * (i >> 2) > query) s[sub][i] = 0.f;
            }
            bf16x8 pf[2][2];
#pragma unroll
            for (int sub = 0; sub < 2; ++sub)
#pragma unroll
                for (int s2 = 0; s2 < 2; ++s2) { u32x4 w; w.x = cvt_pk_bf16(s[sub][8 * s2 + 0], s[sub][8 * s2 + 1]); w.y = cvt_pk_bf16(s[sub][8 * s2 + 2], s[sub][8 * s2 + 3]);
                    w.z = cvt_pk_bf16(s[sub][8 * s2 + 4], s[sub][8 * s2 + 5]); w.w = cvt_pk_bf16(s[sub][8 * s2 + 6], s[sub][8 * s2 + 7]); pf[sub][s2] = __builtin_bit_cast(bf16x8, w); }
#pragma unroll
            for (int ep = 0; ep < NES; ep += 2) {
                bf16x8 vf[2][4];
#pragma unroll
                for (int e = 0; e < 2; ++e)
#pragma unroll
                    for (int kk = 0; kk < 4; ++kk) vf[e][kk] = *(const LAS bf16x8*)(buf + KBYTES + (32 * (ep + e) + r) * VP + (4 * kh + kk) * 32 + hh * 16);
                __builtin_amdgcn_sched_barrier(0);
#pragma unroll
                for (int kk = 0; kk < 4; ++kk)
#pragma unroll
                    for (int e = 0; e < 2; ++e) o[ep + e] = __builtin_amdgcn_mfma_f32_32x32x16_bf16(vf[e][kk], pf[kk >> 1][kk & 1], o[ep + e], 0, 0, 0);
            }
        }
    };
    for (int t = 0; t < nt; t += 2) {
        if (t + 2 < nt) RT_LOAD(ak, av, t + 2);
        compute(t);
        if (t + 1 < nt) RT_STORE(bk, bv, t + 1);
        __syncthreads();
        if (t + 1 >= nt) break;
        if (t + 3 < nt) RT_LOAD(bk, bv, t + 3);
        compute(t + 1);
        if (t + 2 < nt) RT_STORE(ak, av, t + 2);
        __syncthreads();
    }
#undef RT_LOAD
#undef RT_STORE
    LAS float* X = (LAS float*)lds;
    if (kh == 1) {
#pragma unroll
        for (int e = 0; e < NES; ++e)
#pragma unroll
            for (int i = 0; i < 16; ++i) X[((wid & 3) * 64 + e * 16 + i) * 64 + lane] = o[e][i];
    }
    __syncthreads();
    if (kh == 0) {
#pragma unroll
        for (int e = 0; e < NES; ++e)
#pragma unroll
            for (int i = 0; i < 16; ++i) o[e][i] += X[((wid & 3) * 64 + e * 16 + i) * 64 + lane];
        float s1 = 0.f;
#pragma unroll
        for (int e = 0; e < NES; ++e)
#pragma unroll
            for (int i = 0; i < 16; ++i) s1 += o[e][i];
        const float mean = (s1 + __shfl_xor(s1, 32)) * (1.0f / 128.0f); float s2 = 0.f;
#pragma unroll
        for (int e = 0; e < NES; ++e)
#pragma unroll
            for (int i = 0; i < 16; ++i) { o[e][i] -= mean; s2 += o[e][i] * o[e][i]; }
        const float rstd = __builtin_amdgcn_rsqf((s2 + __shfl_xor(s2, 32)) * (1.0f / 128.0f) + EPS);
        const bf16_t* gp = proj + qrow * LDP + PC_RG + hd * 128 + 4 * hh; bf16_t* yp = Y + qrow * 2048 + 512 + hd * 128 + 4 * hh;
#pragma unroll
        for (int e = 0; e < NES; ++e)
#pragma unroll
            for (int g = 0; g < 4; ++g) { const u32x2 gw = *(const u32x2*)(gp + 32 * e + 8 * g);
                u32x2 w; w.x = cvt_pk_bf16(o[e][4 * g] * rstd * bflo(gw.x), o[e][4 * g + 1] * rstd * bfhi(gw.x)); w.y = cvt_pk_bf16(o[e][4 * g + 2] * rstd * bflo(gw.y), o[e][4 * g + 3] * rstd * bfhi(gw.y)); *(u32x2*)(yp + 32 * e + 8 * g) = w; }
    }
    __syncthreads();
}
__device__ __forceinline__ void ret_phase2(LAS unsigned char* lds, const bf16_t* proj, const bf16_t* RVT, bf16_t* Y) {
    const int vid0 = (gridDim.x % 8 == 0) ? (int)((blockIdx.x % 8) * (gridDim.x / 8) + blockIdx.x / 8) : (int)blockIdx.x;
    for (int pr = vid0; pr < 256; pr += gridDim.x) { const int bh = pr >> 3, p = pr & 7;
        ret_item2(lds, bh >> 2, bh & 3, 15 - p, proj, RVT, Y);
        ret_item2(lds, bh >> 2, bh & 3, p, proj, RVT, Y); }
}


__device__ __forceinline__ void kvt_phase(const bf16_t* RVT, const bf16_t* RKT, float* KVT) {
    int tid_ = threadIdx.x; asm volatile("" : "+v"(tid_));
    const int tid = tid_, lane = tid & 63, wid = __builtin_amdgcn_readfirstlane(tid >> 6), r = lane & 31, hh = lane >> 5, es = wid >> 1, ds = wid & 1;
    for (int unit0 = blockIdx.x; unit0 < 512; unit0 += 2 * gridDim.x) {
        const int unit1 = unit0 + gridDim.x; const bool two = unit1 < 512; const int u1 = two ? unit1 : unit0;
        bf16x8 vf[2][8], kf[2][8];
#pragma unroll
        for (int q = 0; q < 2; ++q) { const int unit = q ? u1 : unit0, bh = unit >> 4, m = unit & 15;
            const bf16_t* vp = RVT + ((size_t)bh * 128 + 32 * es + r) * SEQ + 128 * m + 8 * hh;
            const bf16_t* kp = RKT + ((size_t)bh * 64 + 32 * ds + r) * SEQ + 128 * m + 8 * hh;
#pragma unroll
            for (int kk = 0; kk < 8; ++kk) { vf[q][kk] = *(const bf16x8*)(vp + 16 * kk); kf[q][kk] = *(const bf16x8*)(kp + 16 * kk); } }
#pragma unroll
        for (int q = 0; q < 2; ++q) { if (q == 1 && !two) break; const int unit = q ? u1 : unit0;
            f32x16 acc;
#pragma unroll
            for (int i = 0; i < 16; ++i) acc[i] = 0.f;
#pragma unroll
            for (int kk = 0; kk < 8; ++kk) acc = __builtin_amdgcn_mfma_f32_32x32x16_bf16(vf[q][kk], kf[q][kk], acc, 0, 0, 0);
            float* op = KVT + (size_t)unit * 8192 + (size_t)(32 * es + 4 * hh) * 64 + 32 * ds + r;
#pragma unroll
            for (int i = 0; i < 16; ++i) op[(size_t)((i & 3) + 8 * (i >> 2)) * 64] = acc[i]; }
    }
}
__device__ __forceinline__ void ret_chunk_item(LAS unsigned char* lds, int b, int hd, int n, const bf16_t* proj, const bf16_t* VT, const float* KVT, bf16_t* Y) {
    constexpr int NKS = 4, NES = 4, KP = 144, VP = 272, SP = 144;
    constexpr int KBYTES = 128 * KP, ST_OFF = 65536;
    int tid_ = threadIdx.x; asm volatile("" : "+v"(tid_));
    const int tid = tid_, lane = tid & 63, wid = __builtin_amdgcn_readfirstlane(tid >> 6), r = lane & 31, hh = lane >> 5, kh = wid >> 2;
    const int Q0 = n * 128 + (wid & 3) * 32, query = Q0 + r; const size_t qrow = (size_t)b * SEQ + query;
    const float lg2 = __log2f(1.0f - exp2f(-(float)(5 + hd)));
    {
        const bf16_t* gk = proj + ((size_t)b * SEQ + 128 * n + (tid >> 3)) * 1024 + 256 + hd * 64 + (tid & 7) * 8;
        const bf16_t* gv = VT + ((size_t)(b * 4 + hd) * 128 + (tid >> 4)) * SEQ + 128 * n + (tid & 15) * 8;
        const unsigned lk = (tid >> 3) * KP + (tid & 7) * 16, lv = KBYTES + (tid >> 4) * VP + (tid & 15) * 16;
        u32x4 ck[2], cv[4];
#pragma unroll
        for (int i = 0; i < 2; ++i) ck[i] = *(const u32x4*)(gk + (size_t)(64 * i) * 1024);
#pragma unroll
        for (int i = 0; i < 4; ++i) cv[i] = *(const u32x4*)(gv + (size_t)(32 * i) * SEQ);
        f32x4 sa[4];
#pragma unroll
        for (int i = 0; i < 4; ++i) sa[i] = (f32x4){0.f, 0.f, 0.f, 0.f};
        const float* kb = KVT + ((size_t)(b * 4 + hd) * 16) * 8192 + tid * 16;
        for (int m0 = 0; m0 < n; m0 += 8) {
            f32x4 pv[8][4]; float w[8];
#pragma unroll
            for (int j = 0; j < 8; ++j) { const int m = m0 + j, mc = m < n ? m : n - 1; const f32x4* p = (const f32x4*)(kb + (size_t)mc * 8192);
                w[j] = m < n ? fast_exp2((float)(128 * (n - 1 - m)) * lg2) : 0.f;
#pragma unroll
                for (int i = 0; i < 4; ++i) pv[j][i] = p[i]; }
#pragma unroll
            for (int j = 0; j < 8; ++j)
#pragma unroll
                for (int i = 0; i < 4; ++i) sa[i] += pv[j][i] * w[j];
        }
        *(LAS u32x4*)(lds + ST_OFF + (tid >> 2) * SP + (tid & 3) * 32) = pack8(sa[0], sa[1]);
        *(LAS u32x4*)(lds + ST_OFF + (tid >> 2) * SP + (tid & 3) * 32 + 16) = pack8(sa[2], sa[3]);
#pragma unroll
        for (int i = 0; i < 2; ++i) *(LAS u32x4*)(lds + lk + 64 * i * KP) = ck[i];
#pragma unroll
        for (int i = 0; i < 4; ++i) *(LAS u32x4*)(lds + lv + 32 * i * VP) = cv[i];
    }
    bf16x8 qf[NKS];
#pragma unroll
    for (int ks = 0; ks < NKS; ++ks) qf[ks] = *(const bf16x8*)(proj + qrow * 1024 + hd * 64 + ks * 16 + hh * 8);
    f32x16 o[NES];
#pragma unroll
    for (int e = 0; e < NES; ++e)
#pragma unroll
        for (int i = 0; i < 16; ++i) o[e][i] = 0.f;
    __syncthreads();
    const int tile = 2 * n + kh, my_last = Q0 >> 6;
    if (tile <= my_last) {
        f32x16 s[2];
        {
            bf16x8 kf[2][NKS];
#pragma unroll
            for (int sub = 0; sub < 2; ++sub)
#pragma unroll
                for (int ks = 0; ks < NKS; ++ks) kf[sub][ks] = *(const LAS bf16x8*)(lds + (64 * kh + 32 * sub + r) * KP + ks * 32 + hh * 16);
#pragma unroll
            for (int sub = 0; sub < 2; ++sub)
#pragma unroll
                for (int i = 0; i < 16; ++i) s[sub][i] = 0.f;
            __builtin_amdgcn_sched_barrier(0);
#pragma unroll
            for (int ks = 0; ks < NKS; ++ks)
#pragma unroll
                for (int sub = 0; sub < 2; ++sub) s[sub] = __builtin_amdgcn_mfma_f32_32x32x16_bf16(kf[sub][ks], qf[ks], s[sub], 0, 0, 0);
        }
        const int kbase = 64 * tile + 4 * hh;
#pragma unroll
        for (int sub = 0; sub < 2; ++sub)
#pragma unroll
            for (int i = 0; i < 16; ++i) { const int key = kbase + 32 * sub + (i & 3) + 8 * (i >> 2); s[sub][i] = (key > query) ? 0.f : s[sub][i] * fast_exp2((float)(query - key) * lg2); }
        bf16x8 pf[2][2];
#pragma unroll
        for (int sub = 0; sub < 2; ++sub)
#pragma unroll
            for (int s2 = 0; s2 < 2; ++s2) { u32x4 w; w.x = cvt_pk_bf16(s[sub][8 * s2 + 0], s[sub][8 * s2 + 1]); w.y = cvt_pk_bf16(s[sub][8 * s2 + 2], s[sub][8 * s2 + 3]);
                w.z = cvt_pk_bf16(s[sub][8 * s2 + 4], s[sub][8 * s2 + 5]); w.w = cvt_pk_bf16(s[sub][8 * s2 + 6], s[sub][8 * s2 + 7]); pf[sub][s2] = __builtin_bit_cast(bf16x8, w); }
#pragma unroll
        for (int ep = 0; ep < NES; ep += 2) {
            bf16x8 vf[2][4];
#pragma unroll
            for (int e = 0; e < 2; ++e)
#pragma unroll
                for (int kk = 0; kk < 4; ++kk) vf[e][kk] = *(const LAS bf16x8*)(lds + KBYTES + (32 * (ep + e) + r) * VP + (4 * kh + kk) * 32 + hh * 16);
            __builtin_amdgcn_sched_barrier(0);
#pragma unroll
            for (int kk = 0; kk < 4; ++kk)
#pragma unroll
                for (int e = 0; e < 2; ++e) o[ep + e] = __builtin_amdgcn_mfma_f32_32x32x16_bf16(vf[e][kk], pf[kk >> 1][kk & 1], o[ep + e], 0, 0, 0);
        }
    }
    if (n > 0) {
        f32x16 oc[2];
#pragma unroll
        for (int e = 0; e < 2; ++e)
#pragma unroll
            for (int i = 0; i < 16; ++i) oc[e][i] = 0.f;
        bf16x8 sf[2][NKS];
#pragma unroll
        for (int e = 0; e < 2; ++e)
#pragma unroll
            for (int ks = 0; ks < NKS; ++ks) sf[e][ks] = *(const LAS bf16x8*)(lds + ST_OFF + (32 * (2 * kh + e) + r) * SP + ks * 32 + hh * 16);
#pragma unroll
        for (int ks = 0; ks < NKS; ++ks)
#pragma unroll
            for (int e = 0; e < 2; ++e) oc[e] = __builtin_amdgcn_mfma_f32_32x32x16_bf16(sf[e][ks], qf[ks], oc[e], 0, 0, 0);
        const float f = fast_exp2((float)((query & 127) + 1) * lg2);
        if (kh == 0) {
#pragma unroll
            for (int e = 0; e < 2; ++e)
#pragma unroll
                for (int i = 0; i < 16; ++i) o[e][i] += f * oc[e][i];
        } else {
#pragma unroll
            for (int e = 0; e < 2; ++e)
#pragma unroll
                for (int i = 0; i < 16; ++i) o[2 + e][i] += f * oc[e][i];
        }
    }
    __syncthreads();
    LAS float* X = (LAS float*)lds;
    if (kh == 1) {
#pragma unroll
        for (int e = 0; e < NES; ++e)
#pragma unroll
            for (int i = 0; i < 16; ++i) X[((wid & 3) * 64 + e * 16 + i) * 64 + lane] = o[e][i];
    }
    __syncthreads();
    if (kh == 0) {
#pragma unroll
        for (int e = 0; e < NES; ++e)
#pragma unroll
            for (int i = 0; i < 16; ++i) o[e][i] += X[((wid & 3) * 64 + e * 16 + i) * 64 + lane];
        float s1 = 0.f;
#pragma unroll
        for (int e = 0; e < NES; ++e)
#pragma unroll
            for (int i = 0; i < 16; ++i) s1 += o[e][i];
        const float mean = (s1 + __shfl_xor(s1, 32)) * (1.0f / 128.0f); float s2 = 0.f;
#pragma unroll
        for (int e = 0; e < NES; ++e)
#pragma unroll
            for (int i = 0; i < 16; ++i) { o[e][i] -= mean; s2 += o[e][i] * o[e][i]; }
        const float rstd = __builtin_amdgcn_rsqf((s2 + __shfl_xor(s2, 32)) * (1.0f / 128.0f) + EPS);
        const bf16_t* gp = proj + qrow * 1024 + 512 + hd * 128 + 4 * hh; bf16_t* yp = Y + qrow * 2048 + 512 + hd * 128 + 4 * hh;
#pragma unroll
        for (int e = 0; e < NES; ++e)
#pragma unroll
            for (int g = 0; g < 4; ++g) { const u32x2 gw = *(const u32x2*)(gp + 32 * e + 8 * g);
                u32x2 w; w.x = cvt_pk_bf16(o[e][4 * g] * rstd * bflo(gw.x), o[e][4 * g + 1] * rstd * bfhi(gw.x)); w.y = cvt_pk_bf16(o[e][4 * g + 2] * rstd * bflo(gw.y), o[e][4 * g + 3] * rstd * bfhi(gw.y)); *(u32x2*)(yp + 32 * e + 8 * g) = w; }
    }
    __syncthreads();
}
__device__ __forceinline__ void ret_chunk_phase(LAS unsigned char* lds, const bf16_t* proj, const bf16_t* RVT, const float* KVT, bf16_t* Y) {
    const int vid0 = (gridDim.x % 8 == 0) ? (int)((blockIdx.x % 8) * (gridDim.x / 8) + blockIdx.x / 8) : (int)blockIdx.x;
    for (int pr = vid0; pr < 256; pr += gridDim.x) { const int bh = pr >> 3, p = pr & 7;
        ret_chunk_item(lds, bh >> 2, bh & 3, 15 - p, proj, RVT, KVT, Y);
        ret_chunk_item(lds, bh >> 2, bh & 3, p, proj, RVT, KVT, Y); }
}

__device__ __forceinline__ void final_norm(float* out, const float* ssq, const float* gfin) {
    int tid_ = threadIdx.x; asm volatile("" : "+v"(tid_));
    const int lane = tid_ & 63, wave = tid_ >> 6, nw = gridDim.x * 8;
    const f32x4* gr = (const f32x4*)gfin + lane; f32x4 gv[4];
#pragma unroll
    for (int j = 0; j < 4; ++j) gv[j] = gr[64 * j];
    for (int m0 = blockIdx.x * 8 + wave; m0 < MTOT; m0 += 2 * nw) {
        const int m1 = m0 + nw; const bool two = m1 < MTOT;
        f32x4* xa = (f32x4*)(out + (size_t)m0 * 1024) + lane; f32x4* xb2 = (f32x4*)(out + (size_t)(two ? m1 : m0) * 1024) + lane;
        f32x4 va[4], vb[4];
#pragma unroll
        for (int j = 0; j < 4; ++j) { va[j] = xa[64 * j]; vb[j] = xb2[64 * j]; }
        const float ra = rstd16(ssq + (size_t)m0 * 16, 1.0f / 1024.0f), rb = rstd16(ssq + (size_t)(two ? m1 : m0) * 16, 1.0f / 1024.0f);
#pragma unroll
        for (int j = 0; j < 4; ++j) xa[64 * j] = va[j] * ra * gv[j];
        if (two) {
#pragma unroll
            for (int j = 0; j < 4; ++j) xb2[64 * j] = vb[j] * rb * gv[j]; }
    }
}

#define XB_TMO      128
#define XB_XCNT(j)  (256  + 64 * (j))
#define XB_XSUB(j)  (1280 + 64 * (j))
#define XB_XGEN(j)  (2304 + 64 * (j))
#define XB_TOP      3328
#define XB_TOPGEN   3392
#define XCD_BAR_WORDS 3456
#define XB_SPIN_CAP (1u << 20)
__device__ __forceinline__ unsigned xb_ld(unsigned* p)              { return __hip_atomic_load(p, __ATOMIC_RELAXED, __HIP_MEMORY_SCOPE_AGENT); }
__device__ __forceinline__ unsigned xb_add(unsigned* p, unsigned v) { return __hip_atomic_fetch_add(p, v, __ATOMIC_RELAXED, __HIP_MEMORY_SCOPE_AGENT); }
__device__ __forceinline__ unsigned xb_xcc_id() { return (unsigned)__builtin_amdgcn_s_getreg((3 << 11) | 20) & 0xFu; }
#define XB_SPIN(cond, bar) do { unsigned _sp = 0; while (cond) { __builtin_amdgcn_s_sleep(1); \
    if ((++_sp & 255u) == 0u) { if (xb_ld(&(bar)[XB_TMO])) break; if (_sp > XB_SPIN_CAP) { atomicAdd(&(bar)[XB_TMO], 1u); break; } } } } while (0)
struct XcdBarrier { unsigned* bar; unsigned x; volatile LAS unsigned* st; };
__device__ __forceinline__ XcdBarrier xcd_barrier_post(unsigned* bar, volatile LAS unsigned* st) {
    XcdBarrier b; b.bar = bar; b.x = xb_xcc_id(); b.st = st;
    if (threadIdx.x == 0) (void)xb_add(&bar[XB_XCNT(b.x)], 1u);
    return b;
}
__device__ __forceinline__ void xcd_barrier_complete(unsigned* bar, unsigned x, unsigned& nloc, unsigned& nx) {
    const unsigned G = gridDim.x * gridDim.y * gridDim.z;
    unsigned sum, cnt, mine, sp = 0u;
    for (;;) {
        sum = 0u; cnt = 0u; mine = 0u;
#pragma unroll
        for (unsigned j = 0; j < 16; ++j) { const unsigned c = xb_ld(&bar[XB_XCNT(j)]); sum += c; cnt += (c > 0u) ? 1u : 0u; mine = (j == x) ? c : mine; }
        if (sum == G) break;
        __builtin_amdgcn_s_sleep(1);
        if ((++sp & 255u) == 0u) { if (xb_ld(&bar[XB_TMO])) break; if (sp > XB_SPIN_CAP) { atomicAdd(&bar[XB_TMO], 1u); break; } }
    }
    nloc = mine > 0u ? mine : 1u; nx = cnt > 0u ? cnt : 1u;
}
__device__ __forceinline__ void xcd_barrier(const XcdBarrier& b) {
    asm volatile("s_waitcnt vmcnt(0)" ::: "memory");
    __syncthreads();
    if (threadIdx.x == 0) {
        unsigned* bar = b.bar;
        __builtin_amdgcn_s_waitcnt(0);
        unsigned nloc = b.st[0], nx = b.st[1];
        if (nloc == 0u) { xcd_barrier_complete(bar, b.x, nloc, nx); b.st[0] = nloc; b.st[1] = nx; }
        const unsigned old = xb_add(&bar[XB_XSUB(b.x)], 1u);
        const unsigned gen = old / nloc;
        if (old + 1u == (gen + 1u) * nloc) {
            __builtin_amdgcn_fence(__ATOMIC_RELEASE, "agent");
            asm volatile("s_waitcnt vmcnt(0)" ::: "memory");
            const unsigned og = xb_add(&bar[XB_TOP], 1u);
            const unsigned tg = og / nx;
            if (og + 1u == (tg + 1u) * nx) xb_add(&bar[XB_TOPGEN], 1u);
            else XB_SPIN(xb_ld(&bar[XB_TOPGEN]) == tg, bar);
            __builtin_amdgcn_fence(__ATOMIC_ACQUIRE, "agent");
            xb_add(&bar[XB_XGEN(b.x)], 1u);
            asm volatile("s_waitcnt vmcnt(0)" ::: "memory");
        } else {
            XB_SPIN(xb_ld(&bar[XB_XGEN(b.x)]) == gen, bar);
            __builtin_amdgcn_fence(__ATOMIC_ACQUIRE, "agent");
            asm volatile("s_waitcnt vmcnt(0)" ::: "memory");
        }
    }
    __syncthreads();
}

constexpr int LDS_BYTES = 147456;
#ifdef PROBE_SYNC
#define GSYNC() do { xcd_barrier(xbar); xcd_barrier(xbar); } while (0)
#else
#define GSYNC() xcd_barrier(xbar)
#endif
__global__ void __launch_bounds__(512, 2) fwd_kernel(Args a) {
    extern __shared__ __attribute__((aligned(16))) unsigned char lds_raw[];
    LAS unsigned char* lds = (LAS unsigned char*)lds_raw;
    cg::grid_group grid = cg::this_grid();
    unsigned char* ws = a.ws;
    volatile LAS unsigned* xst = (volatile LAS unsigned*)(lds + XST_OFF);
    if (threadIdx.x < 4) xst[threadIdx.x] = 0u;
    if (blockIdx.x == 0) { unsigned* bw = (unsigned*)(ws + OFF_BAR); for (int i = threadIdx.x; i < XCD_BAR_WORDS; i += 512) bw[i] = 0u; }
    __syncthreads();

#ifndef SKIP_P0
    p0_prep(a, lds);
#ifdef PROBE_P0
    __syncthreads(); p0_prep(a, lds);
#endif
#endif

    grid.sync();
    const XcdBarrier xbar = xcd_barrier_post((unsigned*)(ws + OFF_BAR), xst);
    bf16_t* Wb = (bf16_t*)(ws + OFF_W);
    float* tmc0 = (float*)(ws + OFF_TAB); float* tms0 = tmc0 + (size_t)MTOT * 16; float* trc0 = tms0 + (size_t)MTOT * 16; float* trs0 = trc0 + (size_t)MTOT * 32;
    bf16_t* PROJ = (bf16_t*)(ws + OFF_PG); bf16_t* G = (bf16_t*)(ws + OFF_PG); bf16_t* ACT = (bf16_t*)(ws + OFF_PG);
    bf16_t* CQ = (bf16_t*)(ws + OFF_CQ); bf16_t* CKV = (bf16_t*)(ws + OFF_CKV); float* SQQ = (float*)(ws + OFF_SQQ); float* SQKV = (float*)(ws + OFF_SQKV);
    bf16_t* Qb = (bf16_t*)(ws + OFF_Q); bf16_t* KVb = (bf16_t*)(ws + OFF_KV); bf16_t* Y = (bf16_t*)(ws + OFF_Y); bf16_t* MERGED = (bf16_t*)(ws + OFF_KV); bf16_t* VTb = KVb + (size_t)MH * 512; bf16_t* RVT = (bf16_t*)(ws + OFF_RVT); bf16_t* RKT = (bf16_t*)(ws + OFF_RKT); float* KVT = (float*)(ws + OFF_KVT); bf16_t* RQKG = (bf16_t*)(ws + OFF_RQKG);
    for (int l = 0; l < NLAYER; ++l) {
        const bf16_t* WL = Wb + (size_t)l * WL_ELEMS;
        for (int half = 0; half < 2; ++half) {
            const size_t R0 = (size_t)half * MH;
            bf16_t* XB = (bf16_t*)(ws + OFF_XB) + R0 * 1024; float* SSQ = (float*)(ws + OFF_SSQ) + R0 * 16;
            const float* tmc = tmc0 + R0 * 16; const float* tms = tms0 + R0 * 16; const float* trc = trc0 + R0 * 32; const float* trs = trs0 + R0 * 32;
            float* XO = a.out + R0 * 1024;

#ifndef SKIP_INA
            { EpiInA E{SSQ, (const LAS float*)(lds + SPARE_OFF), PROJ, CQ, CKV, SQQ, SQKV, trc, trs, tmc, tms, RVT, RKT, RQKG}; run_gemm(lds, XB, 1024, WL + WO_INA, 1024, 1024, NA_PHYS, E); }
#ifdef PROBE_INA
            { EpiInA E{SSQ, (const LAS float*)(lds + SPARE_OFF), PROJ, CQ, CKV, SQQ, SQKV, trc, trs, tmc, tms, RVT, RKT, RQKG}; run_gemm(lds, XB, 1024, WL + WO_INA, 1024, 1024, NA_PHYS, E); }
#endif
#endif

            GSYNC();

#ifndef SKIP_UQ
            { EpiUpQ E{SQQ, tmc, tms, Qb}; run_gemm(lds, CQ, 512, WL + WO_UQ, 384, 384, 768, E); }
#endif


#ifndef SKIP_UKV
            { EpiUpKV E{SQKV, KVb, VTb}; run_gemm(lds, CKV, 256, WL + WO_UKV, 256, 256, 1024, E); }
#endif


#ifndef SKIP_CONV
            conv_phase(PROJ, a.in[5] + (size_t)l * 3 * 512, Y);
#endif

            __syncthreads();

#ifndef SKIP_SG
            sg_phase2(lds, PROJ, a.in[6] + l * 512, a.in[7] + l * 512, a.in[8] + (size_t)l * 4 * 128 * 128, a.in[9] + l * 4 * 128, Y);
#ifdef PROBE_SG
            sg_phase2(lds, PROJ, a.in[6] + l * 512, a.in[7] + l * 512, a.in[8] + (size_t)l * 4 * 128 * 128, a.in[9] + l * 4 * 128, Y);
#endif
#endif


#ifndef SKIP_RET
            __syncthreads();
            kvt_phase(RVT, RKT, KVT);
#endif

            GSYNC();

#ifndef SKIP_RET
            ret_chunk_phase(lds, RQKG, RVT, KVT, Y);
#ifdef PROBE_RET
            ret_chunk_phase(lds, RQKG, RVT, KVT, Y);
#endif
#endif
#ifndef SKIP_ATT
            attn_phase(lds, Qb, KVb, CQ, VTb, Y);
#ifdef PROBE_ATT
            attn_phase(lds, Qb, KVb, CQ, VTb, Y);
#endif
#endif

            __syncthreads();

#ifndef SKIP_GATE
            { EpiGate E{SSQ, a.in[4] + (size_t)l * 4 * 1024, (const LAS float*)(lds + SPARE_OFF), (const LAS float*)(lds + BL_OFF), G}; run_gemm(lds, XB, 1024, WL + WO_GATE, 1024, 1024, 4096, E); }
#ifdef PROBE_GATE
            { EpiGate E{SSQ, a.in[4] + (size_t)l * 4 * 1024, (const LAS float*)(lds + SPARE_OFF), (const LAS float*)(lds + BL_OFF), G}; run_gemm(lds, XB, 1024, WL + WO_GATE, 1024, 1024, 4096, E); }
#endif
#endif

            GSYNC();

#ifndef SKIP_MERGED
            { EpiMerged E{G, MERGED}; run_gemm(lds, Y, 2048, WL + WO_BR, 2048, 2048, 1024, E); }
#ifdef PROBE_MERGED
            { EpiMerged E{G, MERGED}; run_gemm(lds, Y, 2048, WL + WO_BR, 2048, 2048, 1024, E); }
#endif
#endif

            GSYNC();

#ifndef SKIP_WOUT
            if (l == 0) { EpiRes<true, false> E{a.in[0] + R0 * 1024, nullptr, XB, SSQ}; run_gemm(lds, MERGED, 1024, WL + WO_OUT, 1024, 1024, 1024, E); }
            else { EpiRes<false, false> E{nullptr, nullptr, XB, SSQ}; run_gemm(lds, MERGED, 1024, WL + WO_OUT, 1024, 1024, 1024, E); }
#endif

            if (half == 1) GSYNC();
        }
        {
            bf16_t* XB = (bf16_t*)(ws + OFF_XB); float* SSQ = (float*)(ws + OFF_SSQ); float* XO = a.out;
#ifndef SKIP_FI
            { EpiFfnIn E{SSQ, (const LAS float*)(lds + SPARE_OFF), ACT}; run_gemm(lds, XB, 1024, WL + WO_FI, 1024, 1024, 2 * DFF, E, MTOT); }
#ifdef PROBE_FI
            { EpiFfnIn E{SSQ, (const LAS float*)(lds + SPARE_OFF), ACT}; run_gemm(lds, XB, 1024, WL + WO_FI, 1024, 1024, 2 * DFF, E, MTOT); }
#endif
#endif
            GSYNC();
#ifndef SKIP_FO
            if (l + 1 < NLAYER) { EpiRes<false, false> E{nullptr, nullptr, XB, SSQ}; run_gemm(lds, ACT, DFF, WL + WO_FO, DFF, DFF, 1024, E, MTOT); }
            else { EpiRes<false, true> E{nullptr, XO, XB, SSQ}; run_gemm(lds, ACT, DFF, WL + WO_FO, DFF, DFF, 1024, E, MTOT); }
#endif
            GSYNC();
        }
    }
    final_norm(a.out, (const float*)(ws + OFF_SSQ), a.in[19]);
}

extern "C" void kernel_launch(void* const* d_in, const int* in_sizes, int n_in, void* d_out, int out_size, void* d_ws, size_t ws_size, hipStream_t stream) {
    static int grid = 0;
    if (!grid) {
        int dev = 0, cus = 0, per_cu = 0;
        (void)hipGetDevice(&dev);
        (void)hipDeviceGetAttribute(&cus, hipDeviceAttributeMultiprocessorCount, dev);
        (void)hipFuncSetAttribute((const void*)fwd_kernel, hipFuncAttributeMaxDynamicSharedMemorySize, LDS_BYTES);
        (void)hipOccupancyMaxActiveBlocksPerMultiprocessor(&per_cu, fwd_kernel, 512, LDS_BYTES);
        grid = cus > 0 ? cus : 256;
        if (ws_size < OFF_END) fprintf(stderr, "kernel_launch: workspace too small: %zu < %zu\n", ws_size, (size_t)OFF_END);
        fprintf(stderr, "kernel_launch: cus %d per_cu %d grid %d n_in %d\n", cus, per_cu, grid, n_in);
    }
    Args a{};
    for (int i = 0; i < 20; ++i) a.in[i] = (const float*)d_in[i];
    a.out = (float*)d_out; a.ws = (unsigned char*)d_ws;
    void* args[] = {&a};
    hipError_t e = hipLaunchCooperativeKernel((void*)fwd_kernel, dim3(grid), dim3(512), args, LDS_BYTES, stream);
    if (e != hipSuccess) fprintf(stderr, "kernel_launch: cooperative launch failed: %s\n", hipGetErrorString(e));
}
```
